# Optimizing an MI355X kernel written in HIP

```python
import math
import functools
import jax
import jax.numpy as jnp
from jax import lax
import numpy as np

D_MODEL = 1024
BATCH = 1
SEQ = 16384
DEPTH = 4

GRID_W = 64
CTX_LEN = 256

N_BRANCH = 4
BRANCH_W = 512

S5_H = 16
S5_P = 64
S5_G = BRANCH_W // S5_H

GLA_HEADS = 4
GLA_DK = 64
GLA_DV = BRANCH_W // GLA_HEADS
GLA_QK = GLA_HEADS * GLA_DK
GLA_RANK = 16
GLA_TAU = 16.0
GLA_CHUNK = 64

LRU_BLOCKS = 8
LRU_BW = BRANCH_W // LRU_BLOCKS
LRU_CONV = 4
LRU_CONV_LEFT = 2
LRU_C = 8.0

RW_N = 64
RW_HEADS = BRANCH_W // RW_N
RW_DECAY_LORA = 64
RW_AAA_LORA = 64
RW_GATE_LORA = 128
RW_GN_EPS = 64e-5
RW_DECAY_SCALE = math.exp(-0.5)

FFN_HIDDEN = 2816
FFN_CONV = 3

DN_ALPHA = (2 * DEPTH) ** 0.25
DN_BETA = (8 * DEPTH) ** -0.25
LN_EPS = 1e-6

PROJ_SIZES = (BRANCH_W, GLA_QK, GLA_QK, BRANCH_W, BRANCH_W, BRANCH_W, BRANCH_W, BRANCH_W, BRANCH_W, BRANCH_W)
W_IN = 2 * GLA_QK + 8 * BRANCH_W

kernel_name = 'hybrid_s5_gla_rglru_rwkv7_dit_block'


def layer_norm(x, g, b, eps=LN_EPS):
    xf = x.astype(jnp.float32)
    mu = jnp.mean(xf, -1, keepdims=True)
    var = jnp.mean(jnp.square(xf - mu), -1, keepdims=True)
    y = ((xf - mu) * lax.rsqrt(var + eps)).astype(x.dtype)
    return y if g is None else y * g + b


def rms_norm(x, w, eps=LN_EPS):
    xf = x.astype(jnp.float32)
    y = (xf * lax.rsqrt(jnp.mean(jnp.square(xf), -1, keepdims=True) + eps)).astype(x.dtype)
    return y * w


def _rows(x, grid):
    if not grid:
        return x
    b, n, ch = x.shape
    rows = n // GRID_W
    return x.reshape(b * rows, GRID_W, ch)


def dwconv(x, w, b, left, grid):
    xs = _rows(x, grid)
    n = xs.shape[1]
    width = w.shape[0]
    xp = jnp.pad(xs, ((0, 0), (left, width - 1 - left), (0, 0)))
    y = b
    for k in range(width):
        y = y + w[k] * xp[:, k:k + n]
    return y.reshape(x.shape)


def token_shift(x, grid):
    xs = _rows(x, grid)
    xp = jnp.pad(xs, ((0, 0), (1, 1), (0, 0)))
    return (0.5 * (xp[:, :-2] + xp[:, 2:])).reshape(x.shape)


def _flip(t):
    return jnp.flip(t, axis=1)


def _identity(t):
    return t


def ctx_then_latent(scan_fn, ctx_args, lat_args, s0, reverse):
    f = _flip if reverse else _identity
    y_ctx, s_ctx = scan_fn(*[f(t) for t in ctx_args], s0)
    y_lat, _ = scan_fn(*[f(t) for t in lat_args], s_ctx)
    return jax.tree_util.tree_map(f, y_ctx), jax.tree_util.tree_map(f, y_lat)


def split_cols(t):
    out, start = [], 0
    for size in PROJ_SIZES:
        out.append(t[..., start:start + size])
        start += size
    return out


def cmul(a, b):
    return (a[0] * b[0] - a[1] * b[1], a[0] * b[1] + a[1] * b[0])


def s5_zoh(lam_re, lam_im, log_step):
    dt = jnp.exp(log_step)[:, None]
    mag = jnp.exp(lam_re * dt)
    a_bar = (mag * jnp.cos(lam_im * dt), mag * jnp.sin(lam_im * dt))
    num_re, num_im = a_bar[0] - 1.0, a_bar[1]
    den = lam_re * lam_re + lam_im * lam_im
    factor = ((num_re * lam_re + num_im * lam_im) / den, (num_im * lam_re - num_re * lam_im) / den)
    return a_bar, factor


def s5_scan(a_bar, bu_re, bu_im, s0):
    first = cmul(a_bar, s0)
    bu_re = bu_re.at[:, 0].add(first[0])
    bu_im = bu_im.at[:, 0].add(first[1])
    a_re = jnp.broadcast_to(a_bar[0], bu_re.shape)
    a_im = jnp.broadcast_to(a_bar[1], bu_re.shape)

    def combine(e1, e2):
        a = cmul(e2[:2], e1[:2])
        ab = cmul(e2[:2], e1[2:])
        return (a[0], a[1], ab[0] + e2[2], ab[1] + e2[3])

    _, _, h_re, h_im = lax.associative_scan(combine, (a_re, a_im, bu_re, bu_im), axis=1)
    return (h_re, h_im), (h_re[:, -1], h_im[:, -1])


def s5_mixer(u_c, u_l, lam_re, lam_im, log_step, b_re, b_im, c_re, c_im, d_skip, w_glu):
    def drive(u):
        ug = u.reshape(u.shape[0], u.shape[1], S5_G, S5_H)
        return (jnp.einsum('blgh,gph->blgp', ug, b_re), jnp.einsum('blgh,gph->blgp', ug, b_im))

    bu_c, bu_l = drive(u_c), drive(u_l)
    zero = jnp.zeros((u_c.shape[0], S5_G, S5_P), u_c.dtype)
    s0 = (zero, zero)
    outs = []
    for dr in range(2):
        a_bar, factor = s5_zoh(lam_re[dr], lam_im[dr], log_step[dr])
        outs.append(ctx_then_latent(functools.partial(s5_scan, a_bar), cmul(factor, bu_c),
                                    cmul(factor, bu_l), s0, reverse=dr == 1))

    def readout(h_f, h_b, u):
        h_re, h_im = h_f[0] + h_b[0], h_f[1] + h_b[1]
        y = jnp.einsum('blgp,ghp->blgh', h_re, c_re) - jnp.einsum('blgp,ghp->blgh', h_im, c_im)
        y = jax.nn.gelu(y.reshape(u.shape) + d_skip * u)
        return y * jax.nn.sigmoid(y @ w_glu)

    return (readout(outs[0][0], outs[1][0], u_c), readout(outs[0][1], outs[1][1], u_l))


def gla_chunked(q, k, v, log_a, s0):
    bsz, n_tok, nh, dk = q.shape
    dv = v.shape[-1]
    n_chunk = n_tok // GLA_CHUNK
    q, k, log_a = [t.reshape(bsz, n_chunk, GLA_CHUNK, nh, dk) for t in (q, k, log_a)]
    v = v.reshape(bsz, n_chunk, GLA_CHUNK, nh, dv)
    b = jnp.cumsum(log_a, axis=2)
    b_last = b[:, :, -1]
    b_mid = b[:, :, GLA_CHUNK // 2][:, :, None]
    att = jnp.einsum('bnihk,bnjhk->bnhij', q * jnp.exp(b - b_mid), k * jnp.exp(b_mid - b))
    mask = jnp.tril(jnp.ones((GLA_CHUNK, GLA_CHUNK), dtype=bool))
    att = jnp.where(mask, att, 0.0)
    o_intra = jnp.einsum('bnhij,bnjhv->bnihv', att, v)
    ds = jnp.einsum('bnjhk,bnjhv->bnhkv', k * jnp.exp(b_last[:, :, None] - b), v)
    decay = jnp.exp(b_last)

    def step(s, inp):
        dcy, d = inp
        return dcy[..., None] * s + d, s

    s_final, s_prev = lax.scan(step, s0, (jnp.moveaxis(decay, 1, 0), jnp.moveaxis(ds, 1, 0)))
    s_prev = jnp.moveaxis(s_prev, 0, 1)
    o_inter = jnp.einsum('bnihk,bnhkv->bnihv', q * jnp.exp(b), s_prev)
    return (o_intra + o_inter).reshape(bsz, n_tok, nh, dv), s_final


def gla_mixer(q_c, k_c, v_c, g_c, q_l, k_l, v_l, g_l, w1, w2, bias, norm_w):
    def heads(t, d):
        return t.reshape(t.shape[0], t.shape[1], GLA_HEADS, d)

    def prep(q, k, v):
        return (heads(q * GLA_DK ** -0.5, GLA_DK), heads(k, GLA_DK), heads(v, GLA_DV))

    def log_decay(k, dr):
        return heads(jax.nn.log_sigmoid((k @ w1[dr]) @ w2[dr] + bias[dr]) / GLA_TAU, GLA_DK)

    ctx, lat = prep(q_c, k_c, v_c), prep(q_l, k_l, v_l)
    s0 = jnp.zeros((q_c.shape[0], GLA_HEADS, GLA_DK, GLA_DV), q_c.dtype)
    outs = [ctx_then_latent(gla_chunked, ctx + (log_decay(k_c, dr),), lat + (log_decay(k_l, dr),),
                            s0, reverse=dr == 1) for dr in range(2)]

    def readout(o, g):
        return rms_norm(o, norm_w).reshape(g.shape) * jax.nn.silu(g)

    return (readout(outs[0][0] + outs[1][0], g_c), readout(outs[0][1] + outs[1][1], g_l))


def lru_scan(a, b, s0):
    b = b.at[:, 0].add(a[:, 0] * s0)
    _, h = lax.associative_scan(lambda e1, e2: (e2[0] * e1[0], e2[0] * e1[1] + e2[1]), (a, b), axis=1)
    return h, h[:, -1]


def lru_mixer(x_c, gate_c, x_l, gate_l, conv_w, conv_b, w_a, b_a, w_x, b_x, lam):
    xc = dwconv(x_c, conv_w, conv_b, LRU_CONV_LEFT, grid=False)
    xl = dwconv(x_l, conv_w, conv_b, LRU_CONV_LEFT, grid=True)

    def block_diag(x, w):
        xb = x.reshape(x.shape[0], x.shape[1], LRU_BLOCKS, LRU_BW)
        return jnp.einsum('blni,nij->blnj', xb, w).reshape(x.shape)

    def gates(x, dr):
        r = jax.nn.sigmoid(block_diag(x, w_a[dr]) + b_a[dr])
        i = jax.nn.sigmoid(block_diag(x, w_x[dr]) + b_x[dr])
        log_a = -LRU_C * jax.nn.softplus(-lam[dr]) * r
        return (jnp.exp(log_a), jnp.sqrt(-jnp.expm1(2.0 * log_a)) * (i * x))

    s0 = jnp.zeros((x_c.shape[0], BRANCH_W), x_c.dtype)
    outs = [ctx_then_latent(lru_scan, gates(xc, dr), gates(xl, dr), s0, reverse=dr == 1) for dr in range(2)]
    return ((outs[0][0] + outs[1][0]) * jax.nn.gelu(gate_c), (outs[0][1] + outs[1][1]) * jax.nn.gelu(gate_l))


def rwkv7_scan(r, w, k, v, a, b, s0):
    def step(s, inp):
        rt, wt, kt, vt, at, bt = inp
        sa = jnp.einsum('bhij,bhj->bhi', s, at)
        s = s * wt[:, :, None, :] + sa[..., None] * bt[:, :, None, :] + vt[..., None] * kt[:, :, None, :]
        return s, jnp.einsum('bhij,bhj->bhi', s, rt)

    s_last, y = lax.scan(step, s0, tuple(jnp.moveaxis(t, 1, 0) for t in (r, w, k, v, a, b)))
    return jnp.moveaxis(y, 0, 1), s_last


def rwkv7_mixer(r_c, k_c, v_c, r_l, k_l, v_l, mu, w0, w1, w2, a0, a1, a2, g1, g2, k_k, k_a, r_k, ln_w, ln_b):
    def heads(t):
        return t.reshape(t.shape[0], t.shape[1], RW_HEADS, RW_N)

    def prep(r, k, v, grid):
        r, k, v = [t + mu[j] * (token_shift(t, grid) - t) for j, t in enumerate((r, k, v))]
        kk = heads(k * k_k).astype(jnp.float32)
        kk = kk / jnp.maximum(jnp.sqrt(jnp.sum(kk * kk, -1, keepdims=True)), 1e-12)
        return r, k, v, kk.astype(k.dtype)

    def direction(r, k, v, kk, dr):
        w = jnp.exp(-RW_DECAY_SCALE * jax.nn.sigmoid(w0[dr] + jnp.tanh(k @ w1[dr]) @ w2[dr]))
        a = jax.nn.sigmoid(a0[dr] + (k @ a1[dr]) @ a2[dr])
        k_dir = k * (1.0 + (a - 1.0) * k_a)
        return (heads(r), heads(w), heads(k_dir), heads(v), -kk, kk * heads(a))

    ctx, lat = prep(r_c, k_c, v_c, False), prep(r_l, k_l, v_l, True)
    s0 = jnp.zeros((r_c.shape[0], RW_HEADS, RW_N, RW_N), r_c.dtype)
    outs = [ctx_then_latent(rwkv7_scan, direction(*ctx, dr), direction(*lat, dr), s0, reverse=dr == 1)
            for dr in range(2)]

    def readout(y, r, k, v):
        y = layer_norm(y, ln_w.reshape(RW_HEADS, RW_N), ln_b.reshape(RW_HEADS, RW_N), eps=RW_GN_EPS)
        bonus = jnp.sum(heads(r * k * r_k), -1, keepdims=True) * heads(v)
        g = jax.nn.sigmoid(r @ g1) @ g2
        return (y + bonus).reshape(r.shape) * g

    return (readout(outs[0][0] + outs[1][0], *ctx[:3]), readout(outs[0][1] + outs[1][1], *lat[:3]))


def token_mixing(h_c, h_l, p):
    pc, pl = split_cols(h_c @ p['w_in']), split_cols(h_l @ p['w_in'])
    ya = s5_mixer(pc[0], pl[0], p['s5_lam_re'], p['s5_lam_im'], p['s5_log_step'], p['s5_b_re'],
                  p['s5_b_im'], p['s5_c_re'], p['s5_c_im'], p['s5_d'], p['s5_w_glu'])
    yb = gla_mixer(pc[1], pc[2], pc[3], pc[4], pl[1], pl[2], pl[3], pl[4],
                   p['gla_w1'], p['gla_w2'], p['gla_bias'], p['gla_norm_w'])
    yc = lru_mixer(pc[5], pc[6], pl[5], pl[6], p['lru_conv_w'], p['lru_conv_b'], p['lru_w_a'],
                   p['lru_b_a'], p['lru_w_x'], p['lru_b_x'], p['lru_lam'])
    yd = rwkv7_mixer(pc[7], pc[8], pc[9], pl[7], pl[8], pl[9], p['rw_mu'], p['rw_w0'], p['rw_w1'],
                     p['rw_w2'], p['rw_a0'], p['rw_a1'], p['rw_a2'], p['rw_g1'], p['rw_g2'],
                     p['rw_k_k'], p['rw_k_a'], p['rw_r_k'], p['rw_ln_w'], p['rw_ln_b'])
    return (ya[0], yb[0], yc[0], yd[0]), (ya[1], yb[1], yc[1], yd[1])


def merge(h, ys, p):
    gates = jax.nn.sigmoid(h @ p['w_gate'] + p['b_gate'])
    z = 0.0
    for n in range(N_BRANCH):
        z = z + gates[..., n * D_MODEL:(n + 1) * D_MODEL] * (ys[n] @ p['w_branch'][n])
    return z @ p['w_out']


def conv_ffn(h, p, grid):
    u, v = jnp.split(h @ p['ffn_w_up'], 2, axis=-1)
    u = dwconv(u, p['ffn_conv_w'], p['ffn_conv_b'], 1, grid)
    return (jax.nn.gelu(u) * v) @ p['ffn_w_down']


def trunk_layer(x_c, x_l, c, c_ctx, p, last):
    mod_l = (jax.nn.silu(c) @ p['w_mod'] + p['b_mod'])[:, None, :]
    mod_c = jax.nn.silu(c_ctx) @ p['w_mod'] + p['b_mod']
    sh1_l, sc1_l, g1_l, sh2_l, sc2_l, g2_l = jnp.split(mod_l, 6, axis=-1)
    sh1_c, sc1_c, g1_c, sh2_c, sc2_c, g2_c = jnp.split(mod_c, 6, axis=-1)
    h_l = x_l * (1.0 + sc1_l) + sh1_l
    h_c = x_c * (1.0 + sc1_c) + sh1_c
    ys_c, ys_l = token_mixing(h_c, h_l, p)
    x_l = layer_norm(DN_ALPHA * x_l + g1_l * merge(h_l, ys_l, p), p['ln1_g'], p['ln1_b'])
    f_l = conv_ffn(x_l * (1.0 + sc2_l) + sh2_l, p, grid=True)
    x_l = layer_norm(DN_ALPHA * x_l + g2_l * f_l, p['ln2_g'], p['ln2_b'])
    if not last:
        x_c = layer_norm(DN_ALPHA * x_c + g1_c * merge(h_c, ys_c, p), p['ln1_g'], p['ln1_b'])
        f_c = conv_ffn(x_c * (1.0 + sc2_c) + sh2_c, p, grid=False)
        x_c = layer_norm(DN_ALPHA * x_c + g2_c * f_c, p['ln2_g'], p['ln2_b'])
    return x_c, x_l


def setup_inputs(seed: int = 0) -> dict:
    key = jax.random.key(seed)
    keys = iter(jax.random.split(key, 96))
    f32 = jnp.float32

    def nrm(shape, scale):
        return scale * jax.random.normal(next(keys), shape, f32)

    def unif(shape, lo, hi):
        return jax.random.uniform(next(keys), shape, f32, lo, hi)

    def gain(shape):
        return 1.0 + nrm(shape, 0.02)

    L, D, W, F = DEPTH, D_MODEL, BRANCH_W, FFN_HIDDEN
    lru_p = unif((L, 2, W), 0.9, 0.999) ** (1.0 / LRU_C)
    return {
        'x': nrm((BATCH, SEQ, D), 1.0),
        'c': nrm((BATCH, D), 1.0),
        'ctx': nrm((BATCH, CTX_LEN, D), 1.0),
        'c_ctx': nrm((D,), 1.0),
        'w_mod': nrm((L, D, 6 * D), 0.5 * D ** -0.5),
        'b_mod': nrm((L, 6 * D), 0.02),
        'w_in': nrm((L, D, W_IN), D ** -0.5),
        's5_lam_re': -0.5 + nrm((L, 2, S5_G, S5_P), 0.01),
        's5_lam_im': math.pi * jnp.arange(S5_P, dtype=f32) + nrm((L, 2, S5_G, S5_P), 0.01),
        's5_log_step': unif((L, 2, S5_G), math.log(1e-3), math.log(1e-1)),
        's5_b_re': nrm((L, S5_G, S5_P, S5_H), (2 * S5_H) ** -0.5),
        's5_b_im': nrm((L, S5_G, S5_P, S5_H), (2 * S5_H) ** -0.5),
        's5_c_re': nrm((L, S5_G, S5_H, S5_P), S5_P ** -0.5),
        's5_c_im': nrm((L, S5_G, S5_H, S5_P), S5_P ** -0.5),
        's5_d': nrm((L, W), 1.0),
        's5_w_glu': nrm((L, W, W), W ** -0.5),
        'gla_w1': nrm((L, 2, GLA_QK, GLA_RANK), GLA_QK ** -0.5),
        'gla_w2': nrm((L, 2, GLA_RANK, GLA_QK), GLA_RANK ** -0.5),
        'gla_bias': 2.0 + nrm((L, 2, GLA_QK), 0.5),
        'gla_norm_w': gain((L, GLA_DV)),
        'lru_conv_w': nrm((L, LRU_CONV, W), LRU_CONV ** -0.5),
        'lru_conv_b': nrm((L, W), 0.02),
        'lru_w_a': nrm((L, 2, LRU_BLOCKS, LRU_BW, LRU_BW), LRU_BW ** -0.5),
        'lru_b_a': nrm((L, 2, W), 0.02),
        'lru_w_x': nrm((L, 2, LRU_BLOCKS, LRU_BW, LRU_BW), LRU_BW ** -0.5),
        'lru_b_x': nrm((L, 2, W), 0.02),
        'lru_lam': jnp.log(lru_p) - jnp.log1p(-lru_p),
        'rw_mu': unif((L, 3, W), 0.0, 1.0),
        'rw_w0': nrm((L, 2, W), 0.5),
        'rw_w1': nrm((L, 2, W, RW_DECAY_LORA), W ** -0.5),
        'rw_w2': nrm((L, 2, RW_DECAY_LORA, W), RW_DECAY_LORA ** -0.5),
        'rw_a0': nrm((L, 2, W), 0.5),
        'rw_a1': nrm((L, 2, W, RW_AAA_LORA), W ** -0.5),
        'rw_a2': nrm((L, 2, RW_AAA_LORA, W), RW_AAA_LORA ** -0.5),
        'rw_g1': nrm((L, W, RW_GATE_LORA), W ** -0.5),
        'rw_g2': nrm((L, RW_GATE_LORA, W), RW_GATE_LORA ** -0.5),
        'rw_k_k': 0.85 + nrm((L, W), 0.02),
        'rw_k_a': gain((L, W)),
        'rw_r_k': nrm((L, W), 0.1),
        'rw_ln_w': gain((L, W)),
        'rw_ln_b': nrm((L, W), 0.02),
        'w_branch': nrm((L, N_BRANCH, W, D), W ** -0.5),
        'w_gate': nrm((L, D, N_BRANCH * D), D ** -0.5),
        'b_gate': nrm((L, N_BRANCH * D), 0.02),
        'w_out': nrm((L, D, D), DN_BETA * D ** -0.5),
        'ln1_g': gain((L, D)),
        'ln1_b': nrm((L, D), 0.02),
        'ln2_g': gain((L, D)),
        'ln2_b': nrm((L, D), 0.02),
        'ffn_w_up': nrm((L, D, 2 * F), D ** -0.5),
        'ffn_conv_w': nrm((L, FFN_CONV, F), FFN_CONV ** -0.5),
        'ffn_conv_b': nrm((L, F), 0.02),
        'ffn_w_down': nrm((L, F, D), DN_BETA * F ** -0.5),
    }


def reference(x, c, ctx, c_ctx, w_mod, b_mod, w_in,
              s5_lam_re, s5_lam_im, s5_log_step, s5_b_re, s5_b_im, s5_c_re, s5_c_im, s5_d, s5_w_glu,
              gla_w1, gla_w2, gla_bias, gla_norm_w,
              lru_conv_w, lru_conv_b, lru_w_a, lru_b_a, lru_w_x, lru_b_x, lru_lam,
              rw_mu, rw_w0, rw_w1, rw_w2, rw_a0, rw_a1, rw_a2, rw_g1, rw_g2, rw_k_k, rw_k_a, rw_r_k,
              rw_ln_w, rw_ln_b,
              w_branch, w_gate, b_gate, w_out, ln1_g, ln1_b, ln2_g, ln2_b,
              ffn_w_up, ffn_conv_w, ffn_conv_b, ffn_w_down):
    layer_params = dict(
        w_mod=w_mod, b_mod=b_mod, w_in=w_in,
        s5_lam_re=s5_lam_re, s5_lam_im=s5_lam_im, s5_log_step=s5_log_step, s5_b_re=s5_b_re,
        s5_b_im=s5_b_im, s5_c_re=s5_c_re, s5_c_im=s5_c_im, s5_d=s5_d, s5_w_glu=s5_w_glu,
        gla_w1=gla_w1, gla_w2=gla_w2, gla_bias=gla_bias, gla_norm_w=gla_norm_w,
        lru_conv_w=lru_conv_w, lru_conv_b=lru_conv_b, lru_w_a=lru_w_a, lru_b_a=lru_b_a,
        lru_w_x=lru_w_x, lru_b_x=lru_b_x, lru_lam=lru_lam,
        rw_mu=rw_mu, rw_w0=rw_w0, rw_w1=rw_w1, rw_w2=rw_w2, rw_a0=rw_a0, rw_a1=rw_a1, rw_a2=rw_a2,
        rw_g1=rw_g1, rw_g2=rw_g2, rw_k_k=rw_k_k, rw_k_a=rw_k_a, rw_r_k=rw_r_k,
        rw_ln_w=rw_ln_w, rw_ln_b=rw_ln_b,
        w_branch=w_branch, w_gate=w_gate, b_gate=b_gate, w_out=w_out,
        ln1_g=ln1_g, ln1_b=ln1_b, ln2_g=ln2_g, ln2_b=ln2_b,
        ffn_w_up=ffn_w_up, ffn_conv_w=ffn_conv_w, ffn_conv_b=ffn_conv_b, ffn_w_down=ffn_w_down)
    x_l = layer_norm(x, None, None)
    x_c = layer_norm(ctx, None, None)
    for i in range(DEPTH):
        p = {name: t[i] for name, t in layer_params.items()}
        x_c, x_l = trunk_layer(x_c, x_l, c, c_ctx, p, last=(i == DEPTH - 1))
    return x_l
```

```cpp
#include <hip/hip_runtime.h>
#include <hip/hip_cooperative_groups.h>
#include <cstdio>
#include <cstdint>
namespace cg = cooperative_groups;

#define DI __device__ __forceinline__
#ifndef DUPMASK
#define DUPMASK 0
#endif
#define GSYNC() do { xcd_barrier(xb); if (DUPMASK & 0x800) xcd_barrier(xb); } while (0)
#ifndef PHMASK
#define PHMASK 0xFFFFFFFFu
#endif
#define PHX(k, stmt) do { if (PHMASK & (1u << (k))) { stmt; } } while (0)
#define LAS __attribute__((address_space(3)))
typedef unsigned short bf16;
typedef _Float16 f16;
typedef short bf16x8 __attribute__((ext_vector_type(8)));
typedef float f32x4 __attribute__((ext_vector_type(4)));
typedef float f32x2 __attribute__((ext_vector_type(2)));
typedef unsigned u32x4 __attribute__((ext_vector_type(4)));
typedef unsigned u32x2 __attribute__((ext_vector_type(2)));
typedef _Float16 f16x4 __attribute__((ext_vector_type(4)));

constexpr int D = 1024, CTX = 256, SEQ = 16384, T = CTX + SEQ, NT = T / 64, DEPTH = 4;
constexpr int WIN = 4608, FF = 2816;
constexpr int OFF_S5U = 0, OFF_GQ = 512, OFF_GK = 768, OFF_GV = 1024, OFF_GG = 1536, OFF_LX = 2048, OFF_LG = 2560, OFF_RR = 3072, OFF_RK = 3584, OFF_RV = 4096;
constexpr float DN_ALPHA = 1.6817928305074290f;
constexpr int LDS_BYTES = 73728;
constexpr int NTHREADS = 256;

constexpr size_t al256(size_t x) { return (x + 255) & ~(size_t)255; }
constexpr size_t WS_BAR = 0;
constexpr size_t WS_MOD = 16384;
constexpr size_t WS_XC = al256(WS_MOD + (size_t)4 * 2 * 6144 * 4);
constexpr size_t WS_WB = al256(WS_XC + (size_t)256 * 1024 * 4);
constexpr size_t WB_WIN = 0;
constexpr size_t WB_WG = WB_WIN + (size_t)4608 * 1024;
constexpr size_t WB_WBR = WB_WG + (size_t)4096 * 1024;
constexpr size_t WB_WOUT = WB_WBR + (size_t)4 * 1024 * 512;
constexpr size_t WB_WUP = WB_WOUT + (size_t)1024 * 1024;
constexpr size_t WB_WDN = WB_WUP + (size_t)5632 * 1024;
constexpr size_t WB_GLU = WB_WDN + (size_t)1024 * 2816;
constexpr size_t WB_RW1 = WB_GLU + (size_t)512 * 512;
constexpr size_t WB_RA1 = WB_RW1 + (size_t)2 * 64 * 512;
constexpr size_t WB_RW2 = WB_RA1 + (size_t)2 * 64 * 512;
constexpr size_t WB_RA2 = WB_RW2 + (size_t)2 * 512 * 64;
constexpr size_t WB_RG1 = WB_RA2 + (size_t)2 * 512 * 64;
constexpr size_t WB_RG2 = WB_RG1 + (size_t)128 * 512;
constexpr size_t WB_LWA = WB_RG2 + (size_t)512 * 128;
constexpr size_t WB_LWX = WB_LWA + (size_t)64 * 1024;
constexpr size_t WB_END = WB_LWX + (size_t)64 * 1024;
constexpr size_t WS_H = al256(WS_WB + WB_END * 2);
constexpr size_t WS_RA = al256(WS_H + (size_t)T * 1024 * 2);
constexpr size_t WS_RB = al256(WS_RA + (size_t)T * 4608 * 2);
constexpr size_t WS_RC = al256(WS_RB + (size_t)T * 2048 * 2);
constexpr size_t WS_RW = al256(WS_RC + (size_t)T * 1024 * 2);
constexpr size_t WS_RY = al256(WS_RW + (size_t)4 * T * 512 * 2);
constexpr size_t WS_YT = al256(WS_RY + (size_t)T * 512 * 2);
constexpr size_t WS_S5E = al256(WS_YT + (size_t)T * 512 * 2);
constexpr size_t WS_GDEC = al256(WS_S5E + (size_t)NT * 2 * 32 * 64 * 2 * 4);
constexpr size_t WS_LA = al256(WS_GDEC + (size_t)NT * 2 * 4 * 64 * 4);
constexpr size_t WS_LB = al256(WS_LA + (size_t)NT * 2 * 512 * 4);
constexpr size_t WS_RSEG = al256(WS_LB + (size_t)NT * 2 * 512 * 4);
constexpr size_t WS_GBS = al256(WS_RSEG + (size_t)3 * 16 * 8 * 4096 * 4);
constexpr size_t WS_END = al256(WS_GBS + (size_t)NT * 2 * 4 * 4096 * 4);
static_assert(WS_RC + (size_t)T * 2816 * 2 <= WS_RY, "A2 alias");
static_assert(WS_RA + (size_t)T * 5632 * 2 <= WS_RC, "UV alias");

struct Params {
    const float* in[53];
    float* out;
    unsigned char* ws;
};

typedef __bf16 bf16x2_t __attribute__((ext_vector_type(2)));
DI unsigned pk2(float lo, float hi) { bf16x2_t v; v[0] = (__bf16)lo; v[1] = (__bf16)hi; return __builtin_bit_cast(unsigned, v); }
DI bf16 f2bf(float x) { return (bf16)(pk2(x, 0.f) & 0xffffu); }
DI float bf2f(bf16 h) { return __uint_as_float(((unsigned)h) << 16); }
DI float bflo(unsigned u) { return __uint_as_float(u << 16); }
DI float bfhi(unsigned u) { return __uint_as_float(u & 0xffff0000u); }
DI void unpack4(u32x2 v, float* o) { o[0] = bflo(v.x); o[1] = bfhi(v.x); o[2] = bflo(v.y); o[3] = bfhi(v.y); }
DI u32x2 pack4(float a, float b, float c, float d) { u32x2 r; r.x = pk2(a, b); r.y = pk2(c, d); return r; }
DI float sigm(float x) { return __builtin_amdgcn_rcpf(1.f + __expf(-x)); }
DI float gelu_t(float x) { const float u = 0.7978845608028654f * (x + 0.044715f * x * x * x); return x * sigm(2.f * u); }
DI float silu_(float x) { return x * sigm(x); }
DI float softplus_(float x) { return fmaxf(x, 0.f) + __logf(1.f + __expf(-fabsf(x))); }
DI float tanh_(float x) { return 1.f - 2.f * __builtin_amdgcn_rcpf(__expf(2.f * x) + 1.f); }
DI int otid() { int t = threadIdx.x; asm volatile("" : "+v"(t)); return t; }
DI f32x4 mfma16(bf16x8 a, bf16x8 b, f32x4 c) { return __builtin_amdgcn_mfma_f32_16x16x32_bf16(a, b, c, 0, 0, 0); }
DI int tile_at(int d, int o) { return d == 0 ? o : (o < 4 ? 3 - o : 263 - o); }
DI int order_of(int d, int c) { return d == 0 ? c : (c < 4 ? 3 - c : 263 - c); }
DI float* xrowp(const Params& P, int t) { return t < CTX ? (float*)(P.ws + WS_XC) + (size_t)t * D : P.out + (size_t)(t - CTX) * D; }

template <int CTRL> DI float dpp_add(float x) {
    const int y = __builtin_amdgcn_update_dpp(0, __float_as_int(x), CTRL, 0xF, 0xF, true);
    return x + __int_as_float(y);
}
DI float row16_sum(float x) {
    x = dpp_add<0xB1>(x); x = dpp_add<0x4E>(x); x = dpp_add<0x141>(x); x = dpp_add<0x140>(x); return x;
}
DI float wave_sum(float v) {
#pragma unroll
    for (int o = 1; o < 64; o <<= 1) v += __shfl_xor(v, o);
    return v;
}

#define XB_TMO      128
#define XB_XCNT(j)  (256  + 64 * (j))
#define XB_XSUB(j)  (1280 + 64 * (j))
#define XB_XGEN(j)  (2304 + 64 * (j))
#define XB_TOP      3328
#define XB_TOPGEN   3392
#define XCD_BAR_WORDS 3456
#define XB_SPIN_CAP (1u << 23)
DI unsigned xb_ld(unsigned* p) { return __hip_atomic_load(p, __ATOMIC_RELAXED, __HIP_MEMORY_SCOPE_AGENT); }
DI unsigned xb_add(unsigned* p, unsigned v) { return __hip_atomic_fetch_add(p, v, __ATOMIC_RELAXED, __HIP_MEMORY_SCOPE_AGENT); }
DI unsigned xb_xcc_id() { return (unsigned)__builtin_amdgcn_s_getreg((3 << 11) | 20) & 0xFu; }
#define XB_SPIN(cond, bar) do { unsigned _sp = 0; while (cond) { __builtin_amdgcn_s_sleep(1); \
    if ((++_sp & 255u) == 0u) { if (xb_ld(&(bar)[XB_TMO])) break; if (_sp > XB_SPIN_CAP) { atomicAdd(&(bar)[XB_TMO], 1u); break; } } } } while (0)
struct XcdBarrier { unsigned* bar; unsigned x; volatile LAS unsigned* st; };
DI XcdBarrier xcd_barrier_post(unsigned* bar, volatile LAS unsigned* st) {
    XcdBarrier b; b.bar = bar; b.x = xb_xcc_id(); b.st = st;
    if (threadIdx.x == 0) (void)xb_add(&bar[XB_XCNT(b.x)], 1u);
    return b;
}
DI void xcd_barrier_complete(unsigned* bar, unsigned x, unsigned& nloc, unsigned& nx) {
    const unsigned G = gridDim.x * gridDim.y * gridDim.z;
    unsigned sum, cnt, mine, sp = 0u;
    for (;;) {
        sum = 0u; cnt = 0u; mine = 0u;
#pragma unroll
        for (unsigned j = 0; j < 16; ++j) { const unsigned c = xb_ld(&bar[XB_XCNT(j)]); sum += c; cnt += (c > 0u) ? 1u : 0u; mine = (j == x) ? c : mine; }
        if (sum == G) break;
        __builtin_amdgcn_s_sleep(1);
        if ((++sp & 255u) == 0u) { if (xb_ld(&bar[XB_TMO])) break; if (sp > XB_SPIN_CAP) { atomicAdd(&bar[XB_TMO], 1u); break; } }
    }
    nloc = mine > 0u ? mine : 1u; nx = cnt > 0u ? cnt : 1u;
}
DI void xcd_barrier(const XcdBarrier& b) {
    asm volatile("s_waitcnt vmcnt(0)" ::: "memory");
    __syncthreads();
    if (threadIdx.x == 0) {
        unsigned* bar = b.bar;
        __builtin_amdgcn_s_waitcnt(0);
        unsigned nloc = b.st[0], nx = b.st[1];
        if (nloc == 0u) { xcd_barrier_complete(bar, b.x, nloc, nx); b.st[0] = nloc; b.st[1] = nx; }
        const unsigned old = xb_add(&bar[XB_XSUB(b.x)], 1u);
        const unsigned gen = old / nloc;
        if (old + 1u == (gen + 1u) * nloc) {
            __builtin_amdgcn_fence(__ATOMIC_RELEASE, "agent");
            asm volatile("s_waitcnt vmcnt(0)" ::: "memory");
            const unsigned og = xb_add(&bar[XB_TOP], 1u);
            const unsigned tg = og / nx;
            if (og + 1u == (tg + 1u) * nx) xb_add(&bar[XB_TOPGEN], 1u);
            else XB_SPIN(xb_ld(&bar[XB_TOPGEN]) == tg, bar);
            __builtin_amdgcn_fence(__ATOMIC_ACQUIRE, "agent");
            xb_add(&bar[XB_XGEN(b.x)], 1u);
            asm volatile("s_waitcnt vmcnt(0)" ::: "memory");
        } else {
            XB_SPIN(xb_ld(&bar[XB_XGEN(b.x)]) == gen, bar);
            __builtin_amdgcn_fence(__ATOMIC_ACQUIRE, "agent");
            asm volatile("s_waitcnt vmcnt(0)" ::: "memory");
        }
    }
    __syncthreads();
}

template <int NI> struct AccT { f32x4 v[4][NI]; };
typedef AccT<4> Acc;
template <int NI> DI void acc_zero(AccT<NI>& a) {
    float z = 0.f; asm volatile("" : "+v"(z));
#pragma unroll
    for (int i = 0; i < 4; ++i)
#pragma unroll
        for (int j = 0; j < NI; ++j) a.v[i][j] = (f32x4){z, z, z, z};
}
template <int NI> DI void gemm_kloop1(AccT<NI>& acc, const bf16* __restrict__ A, int lda, const bf16* __restrict__ B, int ldb, int K, unsigned char* smem) {
    bf16* sA = (bf16*)smem;
    bf16* sB = (bf16*)(smem + 32768);
    constexpr int NB = NI;
    constexpr int BSUB = 32 * NI * 32, BBUF = 2 * BSUB;
    const int tid = otid(), lane = tid & 63, wave = tid >> 6, wr = wave >> 1, wc = wave & 1, l15 = lane & 15, quad = lane >> 4;
    const int KT = K / 64;
    u32x4 ra[4], rb[NB];
    const int kq = tid & 7, row0 = tid >> 3;
    const bf16* ga = A + (size_t)row0 * lda + kq * 8;
    const bf16* gb = B + (size_t)row0 * ldb + kq * 8;
    const int loA = (kq >> 2) * 4096 + row0 * 32 + (kq & 3) * 8;
    const int loB = (kq >> 2) * BSUB + row0 * 32 + (kq & 3) * 8;
#pragma unroll
    for (int i = 0; i < 4; ++i) ra[i] = *(const u32x4*)(ga + (size_t)(32 * i) * lda);
#pragma unroll
    for (int i = 0; i < NB; ++i) rb[i] = *(const u32x4*)(gb + (size_t)(32 * i) * ldb);
#pragma unroll
    for (int i = 0; i < 4; ++i) *(u32x4*)(sA + loA + i * 1024) = ra[i];
#pragma unroll
    for (int i = 0; i < NB; ++i) *(u32x4*)(sB + loB + i * 1024) = rb[i];
    __syncthreads();
#pragma unroll 1
    for (int kt = 0; kt < KT; ++kt) {
        const int cur = kt & 1;
        if (kt + 1 < KT) {
#pragma unroll
            for (int i = 0; i < 4; ++i) ra[i] = *(const u32x4*)(ga + (size_t)(32 * i) * lda + (kt + 1) * 64);
#pragma unroll
            for (int i = 0; i < NB; ++i) rb[i] = *(const u32x4*)(gb + (size_t)(32 * i) * ldb + (kt + 1) * 64);
        }
        const bf16* cA = sA + cur * 8192 + (wr * 64 + l15) * 32 + quad * 8;
        const bf16* cB = sB + cur * BBUF + (wc * 16 * NI + l15) * 32 + quad * 8;
#pragma unroll
        for (int sub = 0; sub < 2; ++sub) {
            bf16x8 xf[4], wf[NI];
#pragma unroll
            for (int i = 0; i < 4; ++i) xf[i] = *(const bf16x8*)(cA + sub * 4096 + i * 512);
#pragma unroll
            for (int i = 0; i < NI; ++i) wf[i] = *(const bf16x8*)(cB + sub * BSUB + i * 512);
#pragma unroll
            for (int mi = 0; mi < 4; ++mi)
#pragma unroll
                for (int ni = 0; ni < NI; ++ni) acc.v[mi][ni] = mfma16(wf[ni], xf[mi], acc.v[mi][ni]);
        }
        if (kt + 1 < KT) {
            const int nx = cur ^ 1;
#pragma unroll
            for (int i = 0; i < 4; ++i) *(u32x4*)(sA + nx * 8192 + loA + i * 1024) = ra[i];
#pragma unroll
            for (int i = 0; i < NB; ++i) *(u32x4*)(sB + nx * BBUF + loB + i * 1024) = rb[i];
        }
        __syncthreads();
    }
}

template <int NI, int BMAP = 0> DI void gemm_kloop(AccT<NI>& acc, const bf16* __restrict__ A, int lda, const bf16* __restrict__ B, int ldb, int K, unsigned char* smem) {
    bf16* sA = (bf16*)smem;
    bf16* sB = (bf16*)(smem + 32768);
    constexpr int NB = NI;
    constexpr int BSUB = 32 * NI * 32, BBUF = 2 * BSUB;
    const int tid = otid(), lane = tid & 63, wave = tid >> 6, wr = wave >> 1, wc = wave & 1, l15 = lane & 15, quad = lane >> 4;
    const int KT = K / 64;
    u32x4 ra0[4], rb0[NB], ra1[4], rb1[NB];
    const int kq = tid & 7, row0 = tid >> 3;
    const bf16* ga = A + (size_t)row0 * lda + kq * 8;
    const bf16* gb = B + (size_t)row0 * ldb + kq * 8;
    const int kqs = (kq & 3) ^ (((row0 >> 3) & 1) << 1);
    const int loA = (kq >> 2) * 4096 + row0 * 32 + kqs * 8;
    const int loB = (kq >> 2) * BSUB + row0 * 32 + kqs * 8;
    const int qs = quad ^ (((l15 >> 3) & 1) << 1);
    const bf16* cA0 = sA + (wr * 64 + l15) * 32 + qs * 8;
    const bf16* cB0 = sB + (wc * 16 * NI + l15) * 32 + qs * 8;
#define G_LOAD(RA, RB, KTI) do { _Pragma("unroll") for (int i = 0; i < 4; ++i) RA[i] = *(const u32x4*)(ga + (size_t)(32 * i) * lda + (KTI) * 64); \
                                 _Pragma("unroll") for (int i = 0; i < NB; ++i) RB[i] = *(const u32x4*)(gb + (size_t)(BMAP ? ((i & 1) * FF + (i >> 1) * 32) : 32 * i) * ldb + (KTI) * 64); } while (0)
#define G_STORE(RA, RB, BUF) do { _Pragma("unroll") for (int i = 0; i < 4; ++i) *(u32x4*)(sA + (BUF) * 8192 + loA + i * 1024) = RA[i]; \
                                  _Pragma("unroll") for (int i = 0; i < NB; ++i) *(u32x4*)(sB + (BUF) * BBUF + loB + i * 1024) = RB[i]; } while (0)
#define G_COMPUTE(BUF) do { _Pragma("unroll") for (int sub = 0; sub < 2; ++sub) { bf16x8 xf[4], wf[NI]; \
        _Pragma("unroll") for (int i = 0; i < 4; ++i) xf[i] = *(const bf16x8*)(cA0 + (BUF) * 8192 + sub * 4096 + i * 512); \
        _Pragma("unroll") for (int i = 0; i < NI; ++i) wf[i] = *(const bf16x8*)(cB0 + (BUF) * BBUF + sub * BSUB + i * 512); \
        _Pragma("unroll") for (int mi = 0; mi < 4; ++mi) _Pragma("unroll") for (int ni = 0; ni < NI; ++ni) acc.v[mi][ni] = mfma16(wf[ni], xf[mi], acc.v[mi][ni]); } } while (0)
    G_LOAD(ra0, rb0, 0);
    G_LOAD(ra1, rb1, 1);
    G_STORE(ra0, rb0, 0);
    __syncthreads();
#pragma unroll 1
    for (int kt = 0; kt < KT; kt += 2) {
        if (kt + 2 < KT) G_LOAD(ra0, rb0, kt + 2);
        G_COMPUTE(0);
        G_STORE(ra1, rb1, 1);
        __syncthreads();
        if (kt + 3 < KT) G_LOAD(ra1, rb1, kt + 3);
        G_COMPUTE(1);
        if (kt + 2 < KT) G_STORE(ra0, rb0, 0);
        __syncthreads();
    }
#undef G_LOAD
#undef G_STORE
#undef G_COMPUTE
}

template <int NI> DI void gemm_kloopw(AccT<NI>& acc, const bf16* __restrict__ A, int lda, const bf16* __restrict__ B, int ldb, int K, unsigned char* smem) {
    bf16* sA = (bf16*)smem;
    bf16* sB = (bf16*)(smem + 16384);
    constexpr int NBL = NI / 2, BBUF = 32 * NI * 32;
    const int tid = otid(), lane = tid & 63, wave = tid >> 6, wr = wave >> 1, wc = wave & 1, l15 = lane & 15, quad = lane >> 4;
    const int KT = K / 32;
    u32x4 ra[2], rb[NBL];
    const int kq = tid & 3, row0 = tid >> 2;
    const bf16* ga = A + (size_t)row0 * lda + kq * 8;
    const bf16* gb = B + (size_t)row0 * ldb + kq * 8;
    const int lo = row0 * 32 + (kq ^ (((row0 >> 3) & 1) << 1)) * 8;
    const int qs = quad ^ (((l15 >> 3) & 1) << 1);
    const bf16* cA0 = sA + (wr * 64 + l15) * 32 + qs * 8;
    const bf16* cB0 = sB + (wc * 16 * NI + l15) * 32 + qs * 8;
#pragma unroll
    for (int i = 0; i < 2; ++i) ra[i] = *(const u32x4*)(ga + (size_t)(64 * i) * lda);
#pragma unroll
    for (int i = 0; i < NBL; ++i) rb[i] = *(const u32x4*)(gb + (size_t)(64 * i) * ldb);
#pragma unroll
    for (int i = 0; i < 2; ++i) *(u32x4*)(sA + lo + i * 2048) = ra[i];
#pragma unroll
    for (int i = 0; i < NBL; ++i) *(u32x4*)(sB + lo + i * 2048) = rb[i];
    __syncthreads();
#pragma unroll 1
    for (int kt = 0; kt < KT; ++kt) {
        const int cur = kt & 1;
        if (kt + 1 < KT) {
#pragma unroll
            for (int i = 0; i < 2; ++i) ra[i] = *(const u32x4*)(ga + (size_t)(64 * i) * lda + (kt + 1) * 32);
#pragma unroll
            for (int i = 0; i < NBL; ++i) rb[i] = *(const u32x4*)(gb + (size_t)(64 * i) * ldb + (kt + 1) * 32);
        }
        {
            bf16x8 xf[4];
#pragma unroll
            for (int i = 0; i < 4; ++i) xf[i] = *(const bf16x8*)(cA0 + cur * 4096 + i * 512);
#pragma unroll
            for (int nh = 0; nh < NI / 4; ++nh) {
                bf16x8 wf[4];
#pragma unroll
                for (int i = 0; i < 4; ++i) wf[i] = *(const bf16x8*)(cB0 + cur * BBUF + (nh * 4 + i) * 512);
#pragma unroll
                for (int mi = 0; mi < 4; ++mi)
#pragma unroll
                    for (int ni = 0; ni < 4; ++ni) acc.v[mi][nh * 4 + ni] = mfma16(wf[ni], xf[mi], acc.v[mi][nh * 4 + ni]);
            }
        }
        if (kt + 1 < KT) {
            const int nx = cur ^ 1;
#pragma unroll
            for (int i = 0; i < 2; ++i) *(u32x4*)(sA + nx * 4096 + lo + i * 2048) = ra[i];
#pragma unroll
            for (int i = 0; i < NBL; ++i) *(u32x4*)(sB + nx * BBUF + lo + i * 2048) = rb[i];
        }
        __syncthreads();
    }
}

template <int NI> DI void gemm_k(AccT<NI>& acc, const bf16* A, int lda, const bf16* B, int ldb, int K, unsigned char* smem) {
    if constexpr (NI == 8) gemm_kloopw<8>(acc, A, lda, B, ldb, K, smem); else gemm_kloop<NI>(acc, A, lda, B, ldb, K, smem);
}
template <int KSTEPS> DI f32x4 mma_rows(const bf16* xrow, const bf16* wrow, f32x4 acc) {
#pragma unroll
    for (int s = 0; s < KSTEPS; ++s) acc = mfma16(*(const bf16x8*)(wrow + 32 * s), *(const bf16x8*)(xrow + 32 * s), acc);
    return acc;
}

template <bool NTS = false> DI void ln_row(const float* xin, float* xout, const float* g, const float* b, const float* sc, const float* sh, bf16* hout, int lane) {
    f32x4 v[4]; float s = 0.f;
#pragma unroll
    for (int j = 0; j < 4; ++j) { v[j] = *(const f32x4*)(xin + 4 * lane + 256 * j); s += (v[j][0] + v[j][1]) + (v[j][2] + v[j][3]); }
    const float mean = wave_sum(s) * (1.f / D); float s2 = 0.f;
#pragma unroll
    for (int j = 0; j < 4; ++j) { v[j] = v[j] - mean; s2 += (v[j][0] * v[j][0] + v[j][1] * v[j][1]) + (v[j][2] * v[j][2] + v[j][3] * v[j][3]); }
    const float rstd = rsqrtf(wave_sum(s2) * (1.f / D) + 1e-6f);
#pragma unroll
    for (int j = 0; j < 4; ++j) {
        const int c = 4 * lane + 256 * j;
        f32x4 y = v[j] * rstd;
        if (g) { const f32x4 gg = *(const f32x4*)(g + c), bb = *(const f32x4*)(b + c); y = y * gg + bb; }
        if (xout) { if (NTS) __builtin_nontemporal_store(y, (f32x4*)(xout + c)); else *(f32x4*)(xout + c) = y; }
        if (hout) { const f32x4 s1 = *(const f32x4*)(sc + c), s0 = *(const f32x4*)(sh + c); const f32x4 h = y * (s1 + 1.f) + s0; *(u32x2*)(hout + c) = pack4(h[0], h[1], h[2], h[3]); }
    }
}

struct ConvDesc { const float* src; bf16* dst; int K, N, ldk, ntile; };
DI void conv_tile(const ConvDesc& cd, int tile, unsigned char* smem) {
    float* s = (float*)smem;
    const int tid = otid();
    const int nb = cd.N / 64, kb = tile / nb, nbi = tile % nb, k0 = kb * 64, n0 = nbi * 64;
#pragma unroll
    for (int i = 0; i < 4; ++i) {
        const int r = (tid >> 4) + 16 * i, c4 = tid & 15;
        const f32x4 v = __builtin_nontemporal_load((const f32x4*)(cd.src + (size_t)(k0 + r) * cd.N + n0 + 4 * c4));
        s[r * 65 + 4 * c4 + 0] = v[0]; s[r * 65 + 4 * c4 + 1] = v[1]; s[r * 65 + 4 * c4 + 2] = v[2]; s[r * 65 + 4 * c4 + 3] = v[3];
    }
    __syncthreads();
    {
        const int n = tid >> 2, kq = tid & 3;
        float f[16];
#pragma unroll
        for (int i = 0; i < 16; ++i) f[i] = s[(16 * kq + i) * 65 + n];
        u32x4 o0, o1;
        o0[0] = pk2(f[0], f[1]); o0[1] = pk2(f[2], f[3]); o0[2] = pk2(f[4], f[5]); o0[3] = pk2(f[6], f[7]);
        o1[0] = pk2(f[8], f[9]); o1[1] = pk2(f[10], f[11]); o1[2] = pk2(f[12], f[13]); o1[3] = pk2(f[14], f[15]);
        bf16* d = cd.dst + (size_t)(n0 + n) * cd.ldk + k0 + 16 * kq;
        *(u32x4*)d = o0; *(u32x4*)(d + 8) = o1;
    }
    __syncthreads();
}
DI void conv_items(const Params& P, int l, int first, int stride, unsigned char* smem) {
    bf16* WB = (bf16*)(P.ws + WS_WB);
    int base = 0;
    __syncthreads();
    auto run = [&](const float* src, bf16* dst, int K, int N) {
        ConvDesc cd; cd.src = src; cd.dst = dst; cd.K = K; cd.N = N; cd.ldk = K; cd.ntile = (K / 64) * (N / 64);
        int f = (first - base) % stride; if (f < 0) f += stride;
        for (int tile = f; tile < cd.ntile; tile += stride) conv_tile(cd, tile, smem);
        base += cd.ntile;
    };
    run(P.in[6] + (size_t)l * 1024 * 4608, WB + WB_WIN, 1024, 4608);
    run(P.in[42] + (size_t)l * 1024 * 4096, WB + WB_WG, 1024, 4096);
#pragma unroll 1
    for (int b = 0; b < 4; ++b) run(P.in[41] + ((size_t)l * 4 + b) * 512 * 1024, WB + WB_WBR + (size_t)b * 1024 * 512, 512, 1024);
    run(P.in[44] + (size_t)l * 1024 * 1024, WB + WB_WOUT, 1024, 1024);
    run(P.in[49] + (size_t)l * 1024 * 5632, WB + WB_WUP, 1024, 5632);
    run(P.in[52] + (size_t)l * 2816 * 1024, WB + WB_WDN, 2816, 1024);
    run(P.in[15] + (size_t)l * 512 * 512, WB + WB_GLU, 512, 512);
#pragma unroll 1
    for (int d = 0; d < 2; ++d) {
        run(P.in[29] + ((size_t)l * 2 + d) * 512 * 64, WB + WB_RW1 + (size_t)d * 64 * 512, 512, 64);
        run(P.in[32] + ((size_t)l * 2 + d) * 512 * 64, WB + WB_RA1 + (size_t)d * 64 * 512, 512, 64);
        run(P.in[30] + ((size_t)l * 2 + d) * 64 * 512, WB + WB_RW2 + (size_t)d * 512 * 64, 64, 512);
        run(P.in[33] + ((size_t)l * 2 + d) * 64 * 512, WB + WB_RA2 + (size_t)d * 512 * 64, 64, 512);
    }
    run(P.in[34] + (size_t)l * 512 * 128, WB + WB_RG1, 512, 128);
    run(P.in[35] + (size_t)l * 128 * 512, WB + WB_RG2, 128, 512);
    run(P.in[22] + (size_t)l * 1024 * 64, WB + WB_LWA, 1024, 64);
    run(P.in[24] + (size_t)l * 1024 * 64, WB + WB_LWX, 1024, 64);
    __syncthreads();
}

DI void mod_item(const Params& P, int item, unsigned char* smem) {
    float* sv = (float*)smem;
    float* red = sv + 2048;
    const int tid = otid(), l = item / 96, n = (item % 96) * 64 + (tid & 63), ks = tid >> 6;
    __syncthreads();
    for (int i = tid; i < 1024; i += 256) { sv[i] = silu_(P.in[3][i]); sv[1024 + i] = silu_(P.in[1][i]); }
    __syncthreads();
    const float* w = P.in[4] + (size_t)l * 1024 * 6144 + n;
    float a0 = 0.f, a1 = 0.f;
#pragma unroll 8
    for (int k = ks * 256; k < ks * 256 + 256; ++k) { const float wv = __builtin_nontemporal_load(w + (size_t)k * 6144); a0 += sv[k] * wv; a1 += sv[1024 + k] * wv; }
    red[(ks * 64 + (tid & 63)) * 2] = a0; red[(ks * 64 + (tid & 63)) * 2 + 1] = a1;
    __syncthreads();
    if (tid < 128) {
        const int c = tid & 63, which = tid >> 6;
        float s = 0.f;
        for (int q = 0; q < 4; ++q) s += red[(q * 64 + c) * 2 + which];
        const int nn = (item % 96) * 64 + c;
        ((float*)(P.ws + WS_MOD))[((size_t)l * 2 + which) * 6144 + nn] = s + P.in[5][(size_t)l * 6144 + nn];
    }
    __syncthreads();
}

struct S5C { float ar[2], ai[2], fr[2], fi[2]; };
DI void s5_consts(const Params& P, int l, int g, int p, S5C& k) {
#pragma unroll
    for (int d = 0; d < 2; ++d) {
        const float dt = expf(P.in[9][((size_t)l * 2 + d) * 32 + g]);
        const float lr = P.in[7][(((size_t)l * 2 + d) * 32 + g) * 64 + p], li = P.in[8][(((size_t)l * 2 + d) * 32 + g) * 64 + p];
        const float mag = expf(lr * dt);
        k.ar[d] = mag * cosf(li * dt); k.ai[d] = mag * sinf(li * dt);
        const float nr = k.ar[d] - 1.f, ni = k.ai[d], den = lr * lr + li * li;
        k.fr[d] = (nr * lr + ni * li) / den; k.fi[d] = (ni * lr - nr * li) / den;
    }
}
DI void s5_load_u(const Params& P, int c, int gq, float* us) {
    const bf16* Pm = (const bf16*)(P.ws + WS_RA);
    for (int idx = otid(); idx < 64 * 16; idx += 256) {
        const int tok = idx >> 4, c4 = idx & 15;
        const u32x2 v = *(const u32x2*)(Pm + (size_t)(c * 64 + tok) * WIN + OFF_S5U + gq * 64 + c4 * 4);
        float f[4]; unpack4(v, f);
        *(f32x4*)(us + tok * 64 + c4 * 4) = (f32x4){f[0], f[1], f[2], f[3]};
    }
}
DI void s5_passA(const Params& P, int l, int item, unsigned char* smem) {
    float* us = (float*)smem;
    const int tid = otid(), c = item >> 3, gq = item & 7, gl = tid >> 6, p = tid & 63, g = gq * 4 + gl;
    __syncthreads();
    s5_load_u(P, c, gq, us);
    S5C k; s5_consts(P, l, g, p, k);
    float br[16], bi[16];
    {
        const float* b0 = P.in[10] + (((size_t)l * 32 + g) * 64 + p) * 16; const float* b1 = P.in[11] + (((size_t)l * 32 + g) * 64 + p) * 16;
#pragma unroll
        for (int h = 0; h < 16; ++h) { br[h] = b0[h]; bi[h] = b1[h]; }
    }
    __syncthreads();
    float efr = 0.f, efi = 0.f, ebr = 0.f, ebi = 0.f, pwr = 1.f, pwi = 0.f;
    for (int j = 0; j < 64; ++j) {
        const float* u = us + j * 64 + gl * 16;
        float rr = 0.f, ri = 0.f;
#pragma unroll
        for (int h = 0; h < 16; ++h) { rr += u[h] * br[h]; ri += u[h] * bi[h]; }
        const float bfr = k.fr[0] * rr - k.fi[0] * ri, bfi = k.fr[0] * ri + k.fi[0] * rr;
        const float nfr = k.ar[0] * efr - k.ai[0] * efi + bfr, nfi = k.ar[0] * efi + k.ai[0] * efr + bfi;
        efr = nfr; efi = nfi;
        const float bbr = k.fr[1] * rr - k.fi[1] * ri, bbi = k.fr[1] * ri + k.fi[1] * rr;
        ebr += pwr * bbr - pwi * bbi; ebi += pwr * bbi + pwi * bbr;
        const float npr = pwr * k.ar[1] - pwi * k.ai[1], npi = pwr * k.ai[1] + pwi * k.ar[1];
        pwr = npr; pwi = npi;
    }
    float* E = (float*)(P.ws + WS_S5E);
    *(float2*)(E + ((((size_t)c * 2 + 0) * 32 + g) * 64 + p) * 2) = make_float2(efr, efi);
    *(float2*)(E + ((((size_t)c * 2 + 1) * 32 + g) * 64 + p) * 2) = make_float2(ebr, ebi);
    __syncthreads();
}
DI void s5_carry(const Params& P, int l, int unit) {
    const int id = unit * 256 + otid(), d = id >> 11, g = (id >> 6) & 31, p = id & 63;
    S5C k; s5_consts(P, l, g, p, k);
    float Ar = d ? k.ar[1] : k.ar[0], Ai = d ? k.ai[1] : k.ai[0];
#pragma unroll
    for (int i = 0; i < 6; ++i) { const float nr = Ar * Ar - Ai * Ai, ni = 2.f * Ar * Ai; Ar = nr; Ai = ni; }
    float* E = (float*)(P.ws + WS_S5E);
    float hr = 0.f, hi = 0.f;
    for (int o0 = 0; o0 < NT; o0 += 13) {
        float2 e[13];
#pragma unroll
        for (int i = 0; i < 13; ++i) { const int c = tile_at(d, o0 + i); e[i] = *(const float2*)(E + ((((size_t)c * 2 + d) * 32 + g) * 64 + p) * 2); }
#pragma unroll
        for (int i = 0; i < 13; ++i) {
            const int c = tile_at(d, o0 + i);
            *(float2*)(E + ((((size_t)c * 2 + d) * 32 + g) * 64 + p) * 2) = make_float2(hr, hi);
            const float nr = Ar * hr - Ai * hi + e[i].x, ni = Ar * hi + Ai * hr + e[i].y;
            hr = nr; hi = ni;
        }
    }
}
DI void s5_passC(const Params& P, int l, int item, unsigned char* smem) {
    float* us = (float*)smem;
    bf16* hb = (bf16*)(smem + 16384);
    bf16* ct = (bf16*)(smem + 49664);
    const int tid = otid(), lane = tid & 63, wave = tid >> 6, l15 = lane & 15, quad = lane >> 4;
    const int c = item >> 3, gq = item & 7, gl = tid >> 6, p = tid & 63, g = gq * 4 + gl;
    __syncthreads();
    s5_load_u(P, c, gq, us);
    {
        const float* c0 = P.in[12] + ((size_t)l * 32 + gq * 4) * 16 * 64; const float* c1 = P.in[13] + ((size_t)l * 32 + gq * 4) * 16 * 64;
        for (int idx = tid; idx < 4096; idx += 256) { const int ch = idx >> 6, pp = idx & 63; ct[ch * 136 + pp] = f2bf(c0[idx]); ct[ch * 136 + 64 + pp] = f2bf(-c1[idx]); }
    }
    S5C k; s5_consts(P, l, g, p, k);
    float br[16], bi[16];
    {
        const float* b0 = P.in[10] + (((size_t)l * 32 + g) * 64 + p) * 16; const float* b1 = P.in[11] + (((size_t)l * 32 + g) * 64 + p) * 16;
#pragma unroll
        for (int h = 0; h < 16; ++h) { br[h] = b0[h]; bi[h] = b1[h]; }
    }
    const float* E = (const float*)(P.ws + WS_S5E);
    const float2 h0f = *(const float2*)(E + ((((size_t)c * 2 + 0) * 32 + g) * 64 + p) * 2);
    const float2 h0b = *(const float2*)(E + ((((size_t)c * 2 + 1) * 32 + g) * 64 + p) * 2);
    f32x4 yacc[4];
#pragma unroll
    for (int i = 0; i < 4; ++i) yacc[i] = (f32x4){0.f, 0.f, 0.f, 0.f};
#pragma unroll
    for (int d = 0; d < 2; ++d) {
        float hr = d ? h0b.x : h0f.x, hi = d ? h0b.y : h0f.y;
#pragma unroll
        for (int hs = 0; hs < 2; ++hs) {
            const int hf = d ? 1 - hs : hs;
            __syncthreads();
            for (int q = 0; q < 32; ++q) {
                const int jl = d ? 31 - q : q, j = hf * 32 + jl;
                const float* u = us + j * 64 + gl * 16;
                float rr = 0.f, ri = 0.f;
#pragma unroll
                for (int h = 0; h < 16; ++h) { rr += u[h] * br[h]; ri += u[h] * bi[h]; }
                const float bur = k.fr[d] * rr - k.fi[d] * ri, bui = k.fr[d] * ri + k.fi[d] * rr;
                const float nr = k.ar[d] * hr - k.ai[d] * hi + bur, ni = k.ar[d] * hi + k.ai[d] * hr + bui;
                hr = nr; hi = ni;
                hb[jl * 520 + gl * 128 + p] = f2bf(hr); hb[jl * 520 + gl * 128 + 64 + p] = f2bf(hi);
            }
            __syncthreads();
#pragma unroll
            for (int mt = 0; mt < 2; ++mt)
                yacc[hf * 2 + mt] = mma_rows<4>(hb + (mt * 16 + l15) * 520 + wave * 128 + quad * 8, ct + (wave * 16 + l15) * 136 + quad * 8, yacc[hf * 2 + mt]);
        }
    }
    bf16* YT = (bf16*)(P.ws + WS_YT);
    const f32x4 dsk = *(const f32x4*)(P.in[14] + (size_t)l * 512 + gq * 64 + wave * 16 + quad * 4);
#pragma unroll
    for (int mt = 0; mt < 4; ++mt) {
        const int tok = mt * 16 + l15;
        const f32x4 uu = *(const f32x4*)(us + tok * 64 + wave * 16 + quad * 4);
        *(u32x2*)(YT + (size_t)(c * 64 + tok) * 512 + gq * 64 + wave * 16 + quad * 4) =
            pack4(gelu_t(yacc[mt][0] + dsk[0] * uu[0]), gelu_t(yacc[mt][1] + dsk[1] * uu[1]), gelu_t(yacc[mt][2] + dsk[2] * uu[2]), gelu_t(yacc[mt][3] + dsk[3] * uu[3]));
    }
    __syncthreads();
}

template <int PASS> DI void lru_pass(const Params& P, int l, int item, unsigned char* smem) {
    float* xc = (float*)smem;
    float* xs = (float*)(smem + 16384);
    bf16* wt = (bf16*)(smem + 16384);
    float* al = (float*)(smem + 16384);
    float* bl = (float*)(smem + 32768);
    bf16* xcb = (bf16*)(smem + 53248);
    float* hsum = (float*)(smem + 53248);
    const int tid = otid(), lane = tid & 63, wave = tid >> 6, l15 = lane & 15, quad = lane >> 4;
    const int c = item >> 3, blk = item & 7, t0 = c * 64;
    const int seglo = c < 4 ? 0 : t0, seghi = c < 4 ? CTX : t0 + 64;
    const bf16* Pm = (const bf16*)(P.ws + WS_RA);
    const bf16* WB = (const bf16*)(P.ws + WS_WB);
    __syncthreads();
    for (int idx = tid; idx < 67 * 16; idx += 256) {
        const int r = idx >> 4, c4 = idx & 15, t = t0 - 2 + r;
        f32x4 v = (f32x4){0.f, 0.f, 0.f, 0.f};
        if (t >= seglo && t < seghi) { float f[4]; unpack4(*(const u32x2*)(Pm + (size_t)t * WIN + OFF_LX + blk * 64 + c4 * 4), f); v = (f32x4){f[0], f[1], f[2], f[3]}; }
        *(f32x4*)(xs + r * 64 + c4 * 4) = v;
    }
    __syncthreads();
    {
        const int chl = tid & 63, chg = blk * 64 + chl;
        const float w0 = P.in[20][((size_t)l * 4 + 0) * 512 + chg], w1 = P.in[20][((size_t)l * 4 + 1) * 512 + chg], w2 = P.in[20][((size_t)l * 4 + 2) * 512 + chg], w3 = P.in[20][((size_t)l * 4 + 3) * 512 + chg];
        const float cb = P.in[21][(size_t)l * 512 + chg];
        for (int tok = tid >> 6; tok < 64; tok += 4) {
            const float y = cb + w0 * xs[(tok + 0) * 64 + chl] + w1 * xs[(tok + 1) * 64 + chl] + w2 * xs[(tok + 2) * 64 + chl] + w3 * xs[(tok + 3) * 64 + chl];
            xc[tok * 64 + chl] = y; xcb[tok * 72 + chl] = f2bf(y);
        }
    }
    __syncthreads();
    for (int idx = tid; idx < 4 * 64 * 8; idx += 256) {
        const int q = idx >> 9, j = (idx >> 3) & 63, k8 = idx & 7, d = q >> 1;
        const bf16* src = WB + ((q & 1) ? WB_LWX : WB_LWA) + (size_t)j * 1024 + (d * 8 + blk) * 64 + k8 * 8;
        *(u32x4*)(wt + (q * 64 + j) * 72 + k8 * 8) = *(const u32x4*)src;
    }
    __syncthreads();
    f32x4 acc[16];
#pragma unroll
    for (int i = 0; i < 16; ++i) acc[i] = mma_rows<2>(xcb + (wave * 16 + l15) * 72 + quad * 8, wt + (i * 16 + l15) * 72 + quad * 8, (f32x4){0.f, 0.f, 0.f, 0.f});
    __syncthreads();
    const int tok = wave * 16 + l15;
    float* c8s = (float*)(smem + 69632);
    float* segp = (float*)(smem + 70144);
    float* segh = (float*)(smem + 71168);
    if (tid < 128) c8s[tid] = -8.f * softplus_(-P.in[26][((size_t)l * 2 + (tid >> 6)) * 512 + blk * 64 + (tid & 63)]);
    __syncthreads();
#pragma unroll
    for (int d = 0; d < 2; ++d) {
#pragma unroll
        for (int nt = 0; nt < 4; ++nt) {
            const int j0 = nt * 16 + quad * 4, chg = blk * 64 + j0;
            const f32x4 ba = *(const f32x4*)(P.in[23] + ((size_t)l * 2 + d) * 512 + chg), bx = *(const f32x4*)(P.in[25] + ((size_t)l * 2 + d) * 512 + chg);
            const f32x4 c8 = *(const f32x4*)(c8s + d * 64 + j0);
            const f32x4 xv = *(const f32x4*)(xc + tok * 64 + j0);
            f32x4 av, bv;
#pragma unroll
            for (int r = 0; r < 4; ++r) {
                const float rg = sigm(acc[(2 * d) * 4 + nt][r] + ba[r]), ig = sigm(acc[(2 * d + 1) * 4 + nt][r] + bx[r]);
                const float aa = __expf(c8[r] * rg);
                av[r] = aa; bv[r] = __builtin_amdgcn_sqrtf(fmaxf(1.f - aa * aa, 0.f)) * (ig * xv[r]);
            }
            *(f32x4*)(al + tok * 64 + j0) = av; *(f32x4*)(bl + tok * 64 + j0) = bv;
        }
        __syncthreads();
        {
            const int ch = lane, chg = blk * 64 + ch, part = wave;
            float* LA = (float*)(P.ws + WS_LA); float* LB = (float*)(P.ws + WS_LB);
            float ar[16], br_[16];
            float h = 0.f, ap = 1.f;
#pragma unroll
            for (int q = 0; q < 16; ++q) { const int pos = part * 16 + q, tk = d ? 63 - pos : pos; ar[q] = al[tk * 64 + ch]; br_[q] = bl[tk * 64 + ch]; }
#pragma unroll
            for (int q = 0; q < 16; ++q) { h = ar[q] * h + br_[q]; ap *= ar[q]; }
            segp[part * 64 + ch] = ap; segh[part * 64 + ch] = h;
            __syncthreads();
            float hin = (PASS == 1) ? LB[((size_t)c * 2 + d) * 512 + chg] : 0.f;
            float atot = 1.f;
#pragma unroll
            for (int pp = 0; pp < 4; ++pp) {
                const bool take = (PASS == 0) ? true : (pp < part);
                if (take) { hin = segp[pp * 64 + ch] * hin + segh[pp * 64 + ch]; atot *= segp[pp * 64 + ch]; }
            }
            if (PASS == 0) {
                if (part == 0) { LA[((size_t)c * 2 + d) * 512 + chg] = atot; LB[((size_t)c * 2 + d) * 512 + chg] = hin; }
            } else {
                float hh = hin;
#pragma unroll
                for (int q = 0; q < 16; ++q) {
                    const int pos = part * 16 + q, tk = d ? 63 - pos : pos;
                    hh = ar[q] * hh + br_[q];
                    if (d == 0) hsum[tk * 64 + ch] = hh; else hsum[tk * 64 + ch] += hh;
                }
            }
        }
        __syncthreads();
    }
    if (PASS == 1) {
        bf16* YS = (bf16*)(P.ws + WS_RB);
        for (int idx = tid; idx < 64 * 16; idx += 256) {
            const int tk = idx >> 4, c4 = idx & 15;
            float gf[4]; unpack4(*(const u32x2*)(Pm + (size_t)(t0 + tk) * WIN + OFF_LG + blk * 64 + c4 * 4), gf);
            const f32x4 h = *(const f32x4*)(hsum + tk * 64 + c4 * 4);
            *(u32x2*)(YS + (size_t)(t0 + tk) * 2048 + 1024 + blk * 64 + c4 * 4) = pack4(h[0] * gelu_t(gf[0]), h[1] * gelu_t(gf[1]), h[2] * gelu_t(gf[2]), h[3] * gelu_t(gf[3]));
        }
    }
    __syncthreads();
}
DI void lru_carry(const Params& P, int unit) {
    const int id = unit * 256 + otid(), d = id >> 9, chn = id & 511;
    float* LA = (float*)(P.ws + WS_LA); float* LB = (float*)(P.ws + WS_LB);
    float h = 0.f;
    for (int o0 = 0; o0 < NT; o0 += 13) {
        float a[13], b[13];
#pragma unroll
        for (int i = 0; i < 13; ++i) { const int c = tile_at(d, o0 + i); a[i] = LA[((size_t)c * 2 + d) * 512 + chn]; b[i] = LB[((size_t)c * 2 + d) * 512 + chn]; }
#pragma unroll
        for (int i = 0; i < 13; ++i) { const int c = tile_at(d, o0 + i); LB[((size_t)c * 2 + d) * 512 + chn] = h; h = a[i] * h + b[i]; }
    }
}

DI void gla_prep(const Params& P, int l, int c, int d, int head, unsigned char* smem, float* bs) {
    bf16* w1t = (bf16*)smem;
    bf16* w2t = (bf16*)(smem + 8448);
    bf16* t1 = (bf16*)(smem + 13568);
    const int tid = otid(), lane = tid & 63, wave = tid >> 6, l15 = lane & 15, quad = lane >> 4;
    const bf16* Pm = (const bf16*)(P.ws + WS_RA);
    const float* w1 = P.in[16] + ((size_t)l * 2 + d) * 256 * 16;
    const float* w2 = P.in[17] + ((size_t)l * 2 + d) * 16 * 256;
    for (int idx = tid; idx < 4096; idx += 256) { const int k = idx >> 4, r = idx & 15; w1t[r * 264 + k] = f2bf(w1[idx]); }
    for (int idx = tid; idx < 64 * 32; idx += 256) { const int n = idx >> 5, r = idx & 31; w2t[n * 40 + r] = r < 16 ? f2bf(w2[r * 256 + head * 64 + n]) : (bf16)0; }
    __syncthreads();
    {
        const bf16* xrow = Pm + (size_t)(c * 64 + wave * 16 + l15) * WIN + OFF_GK + quad * 8;
        const f32x4 a = mma_rows<8>(xrow, w1t + l15 * 264 + quad * 8, (f32x4){0.f, 0.f, 0.f, 0.f});
        const int tok = wave * 16 + l15;
        *(u32x2*)(t1 + tok * 40 + quad * 4) = pack4(a[0], a[1], a[2], a[3]);
        *(u32x2*)(t1 + tok * 40 + 16 + quad * 4) = (u32x2){0u, 0u};
    }
    __syncthreads();
    {
        const int tok = wave * 16 + l15;
#pragma unroll
        for (int nt = 0; nt < 4; ++nt) {
            const f32x4 a = mma_rows<1>(t1 + tok * 40 + quad * 8, w2t + (nt * 16 + l15) * 40 + quad * 8, (f32x4){0.f, 0.f, 0.f, 0.f});
            const int n0 = nt * 16 + quad * 4;
            const f32x4 bias = *(const f32x4*)(P.in[18] + ((size_t)l * 2 + d) * 256 + head * 64 + n0);
            f32x4 la;
#pragma unroll
            for (int r = 0; r < 4; ++r) { const float z = a[r] + bias[r]; la[r] = -softplus_(-z) * (1.f / 16.f); }
            *(f32x4*)(bs + tok * 64 + n0) = la;
        }
    }
    __syncthreads();
    {
        float* seg = (float*)smem;
        float v[16]; float run = 0.f;
#pragma unroll
        for (int q = 0; q < 16; ++q) { const int t = d ? wave * 16 + 15 - q : wave * 16 + q; run += bs[t * 64 + lane]; v[q] = run; }
        seg[wave * 64 + lane] = run;
        __syncthreads();
        float off = 0.f;
#pragma unroll
        for (int pp = 0; pp < 4; ++pp) { const bool take = d ? (pp > wave) : (pp < wave); off += take ? seg[pp * 64 + lane] : 0.f; }
#pragma unroll
        for (int q = 0; q < 16; ++q) { const int t = d ? wave * 16 + 15 - q : wave * 16 + q; bs[t * 64 + lane] = v[q] + off; }
    }
    __syncthreads();
}
DI void gla_load_vt(const Params& P, int c, int head, bf16* vt) {
    const bf16* Pm = (const bf16*)(P.ws + WS_RA);
    for (int idx = otid(); idx < 64 * 32; idx += 256) {
        const int tok = idx >> 5, v4 = idx & 31;
        const u32x2 v = *(const u32x2*)(Pm + (size_t)(c * 64 + tok) * WIN + OFF_GV + head * 128 + v4 * 4);
        vt[(v4 * 4 + 0) * 72 + tok] = (bf16)(v.x & 0xffffu); vt[(v4 * 4 + 1) * 72 + tok] = (bf16)(v.x >> 16);
        vt[(v4 * 4 + 2) * 72 + tok] = (bf16)(v.y & 0xffffu); vt[(v4 * 4 + 3) * 72 + tok] = (bf16)(v.y >> 16);
    }
}
DI void gla_passA(const Params& P, int l, int item, unsigned char* smem) {
    float* bs = (float*)(smem + 18688);
    bf16* vt = (bf16*)(smem + 35072);
    bf16* kt = (bf16*)(smem + 53504);
    const int tid = otid(), lane = tid & 63, wave = tid >> 6, l15 = lane & 15, quad = lane >> 4;
    const int head = item & 3, d = (item >> 2) & 1, c = item >> 3;
    const bf16* Pm = (const bf16*)(P.ws + WS_RA);
    __syncthreads();
    gla_prep(P, l, c, d, head, smem, bs);
    {
        float* gbs = (float*)(P.ws + WS_GBS) + (size_t)item * 4096;
        for (int idx = tid; idx < 1024; idx += 256) *(f32x4*)(gbs + idx * 4) = *(const f32x4*)(bs + idx * 4);
    }
    gla_load_vt(P, c, head, vt);
    const int tl = d ? 0 : 63;
    for (int idx = tid; idx < 64 * 16; idx += 256) {
        const int tok = idx >> 4, k4 = idx & 15;
        float kf[4]; unpack4(*(const u32x2*)(Pm + (size_t)(c * 64 + tok) * WIN + OFF_GK + head * 64 + k4 * 4), kf);
#pragma unroll
        for (int r = 0; r < 4; ++r) { const int kk = k4 * 4 + r; kt[kk * 72 + tok] = f2bf(kf[r] * __expf(bs[tl * 64 + kk] - bs[tok * 64 + kk])); }
    }
    if (tid < 64) ((float*)(P.ws + WS_GDEC))[(size_t)item * 64 + tid] = __expf(bs[tl * 64 + tid]);
    __syncthreads();
    bf16* DS = (bf16*)(P.ws + WS_RC) + (size_t)item * 128 * 64;
#pragma unroll
    for (int mt2 = 0; mt2 < 2; ++mt2) {
        const int mt = wave * 2 + mt2;
#pragma unroll
        for (int nt = 0; nt < 4; ++nt) {
            const f32x4 a = mma_rows<2>(vt + (mt * 16 + l15) * 72 + quad * 8, kt + (nt * 16 + l15) * 72 + quad * 8, (f32x4){0.f, 0.f, 0.f, 0.f});
            *(u32x2*)(DS + (size_t)(mt * 16 + l15) * 64 + nt * 16 + quad * 4) = pack4(a[0], a[1], a[2], a[3]);
        }
    }
    __syncthreads();
}
DI void gla_carry(const Params& P, int unit) {
    const int id = unit * 256 + otid(), d = id >> 13, head = (id >> 11) & 3, vv = (id >> 4) & 127, kq = id & 15;
    bf16* S = (bf16*)(P.ws + WS_RC); const float* DEC = (const float*)(P.ws + WS_GDEC);
    float s[4] = {0.f, 0.f, 0.f, 0.f};
    for (int o0 = 0; o0 < NT; o0 += 10) {
        u32x2 dsv[10]; f32x4 dc[10];
#pragma unroll
        for (int i = 0; i < 10; ++i) {
            const size_t it = ((size_t)tile_at(d, o0 + i) * 2 + d) * 4 + head;
            dsv[i] = *(const u32x2*)(S + (it * 128 + vv) * 64 + kq * 4); dc[i] = *(const f32x4*)(DEC + it * 64 + kq * 4);
        }
#pragma unroll
        for (int i = 0; i < 10; ++i) {
            const size_t it = ((size_t)tile_at(d, o0 + i) * 2 + d) * 4 + head;
            *(u32x2*)(S + (it * 128 + vv) * 64 + kq * 4) = pack4(s[0], s[1], s[2], s[3]);
            float f[4]; unpack4(dsv[i], f);
#pragma unroll
            for (int r = 0; r < 4; ++r) s[r] = dc[i][r] * s[r] + f[r];
        }
    }
}
DI void gla_passC(const Params& P, int l, int item, unsigned char* smem) {
    bf16* att = (bf16*)smem;
    float* bs = (float*)(smem + 18688);
    bf16* qe = (bf16*)(smem + 35072);
    bf16* ke = (bf16*)(smem + 44288);
    bf16* vs = (bf16*)(smem + 53504);
    const int tid = otid(), lane = tid & 63, wave = tid >> 6, l15 = lane & 15, quad = lane >> 4;
    const int head = item & 3, c = item >> 2;
    const bf16* Pm = (const bf16*)(P.ws + WS_RA);
    f32x4 o[8];
#pragma unroll
    for (int i = 0; i < 8; ++i) o[i] = (f32x4){0.f, 0.f, 0.f, 0.f};
    __syncthreads();
    for (int d = 0; d < 2; ++d) {
        {
            const float* gbs = (const float*)(P.ws + WS_GBS) + (size_t)((c * 2 + d) * 4 + head) * 4096;
            for (int idx = tid; idx < 1024; idx += 256) *(f32x4*)(bs + idx * 4) = *(const f32x4*)(gbs + idx * 4);
            __syncthreads();
        }
        const int tm = d ? 31 : 32;
        for (int idx = tid; idx < 64 * 16; idx += 256) {
            const int tok = idx >> 4, k4 = idx & 15;
            float qf[4], kf[4];
            unpack4(*(const u32x2*)(Pm + (size_t)(c * 64 + tok) * WIN + OFF_GQ + head * 64 + k4 * 4), qf);
            unpack4(*(const u32x2*)(Pm + (size_t)(c * 64 + tok) * WIN + OFF_GK + head * 64 + k4 * 4), kf);
            float qo[4], ko[4];
#pragma unroll
            for (int r = 0; r < 4; ++r) { const int kk = k4 * 4 + r; const float db = bs[tok * 64 + kk] - bs[tm * 64 + kk]; qo[r] = qf[r] * 0.125f * __expf(db); ko[r] = kf[r] * __expf(-db); }
            *(u32x2*)(qe + tok * 72 + k4 * 4) = pack4(qo[0], qo[1], qo[2], qo[3]);
            *(u32x2*)(ke + tok * 72 + k4 * 4) = pack4(ko[0], ko[1], ko[2], ko[3]);
        }
        gla_load_vt(P, c, head, vs);
        __syncthreads();
        {
            const int i = wave * 16 + l15;
#pragma unroll
            for (int nt = 0; nt < 4; ++nt) {
                f32x4 a = mma_rows<2>(qe + i * 72 + quad * 8, ke + (nt * 16 + l15) * 72 + quad * 8, (f32x4){0.f, 0.f, 0.f, 0.f});
#pragma unroll
                for (int r = 0; r < 4; ++r) { const int j = nt * 16 + quad * 4 + r; const bool keep = d ? (j >= i) : (j <= i); a[r] = keep ? a[r] : 0.f; }
                *(u32x2*)(att + i * 72 + nt * 16 + quad * 4) = pack4(a[0], a[1], a[2], a[3]);
            }
        }
        __syncthreads();
#pragma unroll
        for (int nt = 0; nt < 8; ++nt) o[nt] = mma_rows<2>(att + (wave * 16 + l15) * 72 + quad * 8, vs + (nt * 16 + l15) * 72 + quad * 8, o[nt]);
        __syncthreads();
        {
            const bf16* S = (const bf16*)(P.ws + WS_RC) + (((size_t)c * 2 + d) * 4 + head) * 128 * 64;
            for (int idx = tid; idx < 128 * 16; idx += 256) {
                const int vv = idx >> 4, k4 = idx & 15;
                float f[4]; unpack4(*(const u32x2*)(S + (size_t)vv * 64 + k4 * 4), f);
#pragma unroll
                for (int r = 0; r < 4; ++r) f[r] *= __expf(bs[tm * 64 + k4 * 4 + r]);
                *(u32x2*)(vs + vv * 72 + k4 * 4) = pack4(f[0], f[1], f[2], f[3]);
            }
        }
        __syncthreads();
#pragma unroll
        for (int nt = 0; nt < 8; ++nt) o[nt] = mma_rows<2>(qe + (wave * 16 + l15) * 72 + quad * 8, vs + (nt * 16 + l15) * 72 + quad * 8, o[nt]);
        __syncthreads();
    }
    float ss = 0.f;
#pragma unroll
    for (int nt = 0; nt < 8; ++nt)
#pragma unroll
        for (int r = 0; r < 4; ++r) ss += o[nt][r] * o[nt][r];
    ss += __shfl_xor(ss, 16); ss += __shfl_xor(ss, 32);
    const float rstd = rsqrtf(ss * (1.f / 128.f) + 1e-6f);
    const int t = c * 64 + wave * 16 + l15;
    bf16* YS = (bf16*)(P.ws + WS_RB);
#pragma unroll
    for (int nt = 0; nt < 8; ++nt) {
        const int vv = nt * 16 + quad * 4;
        const f32x4 nw = *(const f32x4*)(P.in[19] + (size_t)l * 128 + vv);
        float gf[4]; unpack4(*(const u32x2*)(Pm + (size_t)t * WIN + OFF_GG + head * 128 + vv), gf);
        *(u32x2*)(YS + (size_t)t * 2048 + 512 + head * 128 + vv) =
            pack4(o[nt][0] * rstd * nw[0] * silu_(gf[0]), o[nt][1] * rstd * nw[1] * silu_(gf[1]), o[nt][2] * rstd * nw[2] * silu_(gf[2]), o[nt][3] * rstd * nw[3] * silu_(gf[3]));
    }
    __syncthreads();
}

DI void rw_mix4(const bf16* Pm, int t, int col, const float* mu, float* o) {
    const int seglo = t < CTX ? 0 : (t & ~63), seghi = t < CTX ? CTX : seglo + 64;
    float x[4], xm[4] = {0.f, 0.f, 0.f, 0.f}, xp[4] = {0.f, 0.f, 0.f, 0.f};
    unpack4(*(const u32x2*)(Pm + (size_t)t * WIN + col), x);
    if (t > seglo) unpack4(*(const u32x2*)(Pm + (size_t)(t - 1) * WIN + col), xm);
    if (t + 1 < seghi) unpack4(*(const u32x2*)(Pm + (size_t)(t + 1) * WIN + col), xp);
#pragma unroll
    for (int r = 0; r < 4; ++r) o[r] = x[r] + mu[r] * (0.5f * (xm[r] + xp[r]) - x[r]);
}
DI void rw_build_chunk(const Params& P, int l, int c, int which, int kc, bf16* kx) {
    const bf16* Pm = (const bf16*)(P.ws + WS_RA);
    const int off = which == 0 ? OFF_RR : (which == 1 ? OFF_RK : OFF_RV);
    for (int idx = otid(); idx < 64 * 32; idx += 256) {
        const int tok = idx >> 5, c4 = idx & 31, col = kc * 128 + c4 * 4;
        const f32x4 mu = *(const f32x4*)(P.in[27] + ((size_t)l * 3 + which) * 512 + col);
        float muf[4] = {mu[0], mu[1], mu[2], mu[3]}, o[4];
        rw_mix4(Pm, c * 64 + tok, off + col, muf, o);
        *(u32x2*)(kx + tok * 136 + c4 * 4) = pack4(o[0], o[1], o[2], o[3]);
    }
}
DI void rw_prep(const Params& P, int l, int item, unsigned char* smem) {
    bf16* kx = (bf16*)smem;
    bf16* w1c = (bf16*)(smem + 17408);
    bf16* a1c = (bf16*)(smem + 34816);
    bf16* hws = (bf16*)smem;
    bf16* has = (bf16*)(smem + 9216);
    bf16* w2c = (bf16*)(smem + 18432);
    bf16* a2c = (bf16*)(smem + 36864);
    const int tid = otid(), lane = tid & 63, wave = tid >> 6, l15 = lane & 15, quad = lane >> 4;
    const int c = item >> 1, d = item & 1;
    const bf16* WB = (const bf16*)(P.ws + WS_WB);
    f32x4 aw[4], aa[4];
#pragma unroll
    for (int i = 0; i < 4; ++i) { aw[i] = (f32x4){0.f, 0.f, 0.f, 0.f}; aa[i] = (f32x4){0.f, 0.f, 0.f, 0.f}; }
    for (int kc = 0; kc < 4; ++kc) {
        __syncthreads();
        rw_build_chunk(P, l, c, 1, kc, kx);
        for (int idx = tid; idx < 64 * 16; idx += 256) {
            const int n = idx >> 4, k8 = idx & 15;
            *(u32x4*)(w1c + n * 136 + k8 * 8) = *(const u32x4*)(WB + WB_RW1 + ((size_t)d * 64 + n) * 512 + kc * 128 + k8 * 8);
            *(u32x4*)(a1c + n * 136 + k8 * 8) = *(const u32x4*)(WB + WB_RA1 + ((size_t)d * 64 + n) * 512 + kc * 128 + k8 * 8);
        }
        __syncthreads();
#pragma unroll
        for (int nt = 0; nt < 4; ++nt) {
            aw[nt] = mma_rows<4>(kx + (wave * 16 + l15) * 136 + quad * 8, w1c + (nt * 16 + l15) * 136 + quad * 8, aw[nt]);
            aa[nt] = mma_rows<4>(kx + (wave * 16 + l15) * 136 + quad * 8, a1c + (nt * 16 + l15) * 136 + quad * 8, aa[nt]);
        }
    }
    __syncthreads();
    {
        const int tok = wave * 16 + l15;
#pragma unroll
        for (int nt = 0; nt < 4; ++nt) {
            *(u32x2*)(hws + tok * 72 + nt * 16 + quad * 4) = pack4(tanh_(aw[nt][0]), tanh_(aw[nt][1]), tanh_(aw[nt][2]), tanh_(aw[nt][3]));
            *(u32x2*)(has + tok * 72 + nt * 16 + quad * 4) = pack4(aa[nt][0], aa[nt][1], aa[nt][2], aa[nt][3]);
        }
    }
    f16* WA = (f16*)(P.ws + WS_RW) + (size_t)d * T * 512;
    f16* AG = (f16*)(P.ws + WS_RW) + (size_t)(2 + d) * T * 512;
    for (int nc = 0; nc < 4; ++nc) {
        __syncthreads();
        for (int idx = tid; idx < 128 * 8; idx += 256) {
            const int n = idx >> 3, k8 = idx & 7;
            *(u32x4*)(w2c + n * 72 + k8 * 8) = *(const u32x4*)(WB + WB_RW2 + ((size_t)d * 512 + nc * 128 + n) * 64 + k8 * 8);
            *(u32x4*)(a2c + n * 72 + k8 * 8) = *(const u32x4*)(WB + WB_RA2 + ((size_t)d * 512 + nc * 128 + n) * 64 + k8 * 8);
        }
        __syncthreads();
        const int tok = wave * 16 + l15, t = c * 64 + tok;
#pragma unroll
        for (int nt = 0; nt < 8; ++nt) {
            const f32x4 zw = mma_rows<2>(hws + tok * 72 + quad * 8, w2c + (nt * 16 + l15) * 72 + quad * 8, (f32x4){0.f, 0.f, 0.f, 0.f});
            const f32x4 za = mma_rows<2>(has + tok * 72 + quad * 8, a2c + (nt * 16 + l15) * 72 + quad * 8, (f32x4){0.f, 0.f, 0.f, 0.f});
            const int n = nc * 128 + nt * 16 + quad * 4;
            const f32x4 w0 = *(const f32x4*)(P.in[28] + ((size_t)l * 2 + d) * 512 + n), a0 = *(const f32x4*)(P.in[31] + ((size_t)l * 2 + d) * 512 + n);
            f16x4 wo, ao;
#pragma unroll
            for (int r = 0; r < 4; ++r) { wo[r] = (f16)__expf(-0.6065306597126334f * sigm(w0[r] + zw[r])); ao[r] = (f16)sigm(a0[r] + za[r]); }
            *(f16x4*)(WA + (size_t)t * 512 + n) = wo; *(f16x4*)(AG + (size_t)t * 512 + n) = ao;
        }
    }
    __syncthreads();
}
constexpr int NSEG = 8, SEGQ = NT * 4 / NSEG;
struct RwRaw { u32x2 r[3], k[3], v[3]; f16x4 w, a; };
struct RwStep { f32x4 w0, w1, a0, a1, b0, b1, k0, k1, r0, r1; float v; };
DI float dot8(f32x4 x0, f32x4 x1, f32x4 y0, f32x4 y1) {
    f32x2 acc = __builtin_shufflevector(x0, x0, 0, 1) * __builtin_shufflevector(y0, y0, 0, 1);
    acc = __builtin_shufflevector(x0, x0, 2, 3) * __builtin_shufflevector(y0, y0, 2, 3) + acc;
    acc = __builtin_shufflevector(x1, x1, 0, 1) * __builtin_shufflevector(y1, y1, 0, 1) + acc;
    acc = __builtin_shufflevector(x1, x1, 2, 3) * __builtin_shufflevector(y1, y1, 2, 3) + acc;
    return acc[0] + acc[1];
}
DI float row8_sum(float x) { x = dpp_add<0xB1>(x); x = dpp_add<0x4E>(x); x = dpp_add<0x141>(x); return x; }
template <int MODE> DI void rw_scan(const Params& P, int l, int unit, unsigned char* smem) {
    float* ops = (float*)smem;
    float* ybuf = (float*)(smem + 49152);
    const int tid = otid(), lane = tid & 63, wave = tid >> 6;
    const int half = unit & 1, seg = (unit >> 1) % NSEG, hd = (unit >> 1) / NSEG, d = hd >> 3, head = hd & 7;
    const bf16* Pm = (const bf16*)(P.ws + WS_RA);
    const f16* WA = (const f16*)(P.ws + WS_RW) + (size_t)d * T * 512;
    const f16* AG = (const f16*)(P.ws + WS_RW) + (size_t)(2 + d) * T * 512;
    bf16* Yout = d == 0 ? (bf16*)(P.ws + WS_RB) + 1536 : (bf16*)(P.ws + WS_RY);
    const int ystride = d == 0 ? 2048 : 512;
    float* RSEG = (float*)(P.ws + WS_RSEG);
    const int stok = tid >> 4, cg = tid & 15, col = head * 64 + cg * 4;
    const f32x4 mu_r = *(const f32x4*)(P.in[27] + ((size_t)l * 3 + 0) * 512 + col), mu_k = *(const f32x4*)(P.in[27] + ((size_t)l * 3 + 1) * 512 + col), mu_v = *(const f32x4*)(P.in[27] + ((size_t)l * 3 + 2) * 512 + col);
    const f32x4 kkw = *(const f32x4*)(P.in[36] + (size_t)l * 512 + col), kaw = *(const f32x4*)(P.in[37] + (size_t)l * 512 + col);
    const int r8 = lane >> 3, c8 = lane & 7, rowl = wave * 8 + r8, row = half * 32 + rowl;
    f32x4 s0, s1;
    if (MODE == 0) { s0 = (f32x4){0.f, 0.f, 0.f, 0.f}; s1 = s0; }
    else if (MODE == 1) {
#pragma unroll
        for (int i = 0; i < 4; ++i) { s0[i] = (c8 * 8 + i == row) ? 1.f : 0.f; s1[i] = (c8 * 8 + 4 + i == row) ? 1.f : 0.f; }
    } else {
        float* Sl = (float*)smem;
        float* Pl = Sl + 2048;
        s0 = (f32x4){0.f, 0.f, 0.f, 0.f}; s1 = s0;
        for (int sg = 0; sg < seg; ++sg) {
            const float* Ls = RSEG + (((size_t)0 * 16 + hd) * NSEG + sg) * 4096;
            const float* Ps = RSEG + (((size_t)1 * 16 + hd) * NSEG + sg) * 4096;
            __syncthreads();
            *(f32x4*)(Sl + rowl * 64 + c8 * 8) = s0; *(f32x4*)(Sl + rowl * 64 + c8 * 8 + 4) = s1;
            for (int idx = tid; idx < 1024; idx += 256) *(f32x4*)(Pl + idx * 4) = *(const f32x4*)(Ps + idx * 4);
            __syncthreads();
            f32x4 a0 = *(const f32x4*)(Ls + row * 64 + c8 * 8), a1 = *(const f32x4*)(Ls + row * 64 + c8 * 8 + 4);
#pragma unroll 8
            for (int m = 0; m < 64; ++m) {
                const float sv = Sl[rowl * 64 + m];
                a0 += *(const f32x4*)(Pl + m * 64 + c8 * 8) * sv; a1 += *(const f32x4*)(Pl + m * 64 + c8 * 8 + 4) * sv;
            }
            s0 = a0; s1 = a1;
        }
    }
    RwRaw raw;
    auto tok_of = [&](int q, int j) -> int { const int o = q >> 2, sub = q & 3, c = tile_at(d, o), pos = sub * 16 + j; return c * 64 + (d ? 63 - pos : pos); };
    auto prefetch = [&](int q) {
        const int t = tok_of(q, stok);
        const int seglo = t < CTX ? 0 : (t & ~63), seghi = t < CTX ? CTX : seglo + 64;
        const int tm = t > seglo ? t - 1 : t, tp = t + 1 < seghi ? t + 1 : t;
        const bf16* b0 = Pm + (size_t)t * WIN + col; const bf16* bm = Pm + (size_t)tm * WIN + col; const bf16* bp = Pm + (size_t)tp * WIN + col;
        raw.r[0] = *(const u32x2*)(bm + OFF_RR); raw.r[1] = *(const u32x2*)(b0 + OFF_RR); raw.r[2] = *(const u32x2*)(bp + OFF_RR);
        raw.k[0] = *(const u32x2*)(bm + OFF_RK); raw.k[1] = *(const u32x2*)(b0 + OFF_RK); raw.k[2] = *(const u32x2*)(bp + OFF_RK);
        raw.v[0] = *(const u32x2*)(bm + OFF_RV); raw.v[1] = *(const u32x2*)(b0 + OFF_RV); raw.v[2] = *(const u32x2*)(bp + OFF_RV);
        raw.w = *(const f16x4*)(WA + (size_t)t * 512 + col); raw.a = *(const f16x4*)(AG + (size_t)t * 512 + col);
    };
    auto stage = [&](int q, int buf) {
        const int t = tok_of(q, stok);
        const int seglo = t < CTX ? 0 : (t & ~63), seghi = t < CTX ? CTX : seglo + 64;
        const float mm = t > seglo ? 0.5f : 0.f, mp = t + 1 < seghi ? 0.5f : 0.f;
        float rm[4], r0[4], rp[4], km[4], k0[4], kp[4], vm[4], v0[4], vp[4];
        unpack4(raw.r[0], rm); unpack4(raw.r[1], r0); unpack4(raw.r[2], rp);
        unpack4(raw.k[0], km); unpack4(raw.k[1], k0); unpack4(raw.k[2], kp);
        unpack4(raw.v[0], vm); unpack4(raw.v[1], v0); unpack4(raw.v[2], vp);
        f32x4 rr, kk, vv, kd, aa, bb, ww; float ssq = 0.f;
#pragma unroll
        for (int i = 0; i < 4; ++i) {
            rr[i] = r0[i] + mu_r[i] * (mm * rm[i] + mp * rp[i] - r0[i]);
            const float kx = k0[i] + mu_k[i] * (mm * km[i] + mp * kp[i] - k0[i]);
            vv[i] = v0[i] + mu_v[i] * (mm * vm[i] + mp * vp[i] - v0[i]);
            const float kr = kx * kkw[i]; kk[i] = kr; ssq += kr * kr;
            const float ag = (float)raw.a[i];
            kd[i] = kx * (1.f + (ag - 1.f) * kaw[i]); bb[i] = ag; ww[i] = (float)raw.w[i];
        }
        ssq = row16_sum(ssq);
        const float inv = __builtin_amdgcn_rsqf(fmaxf(ssq, 1e-24f));
#pragma unroll
        for (int i = 0; i < 4; ++i) { const float kn = kk[i] * inv; aa[i] = -kn; bb[i] = kn * bb[i]; }
        float* op = ops + ((size_t)buf * 16 + stok) * 384 + cg * 4;
        *(f32x4*)(op + 0) = ww; *(f32x4*)(op + 64) = aa; *(f32x4*)(op + 128) = bb;
        if (MODE != 1) { *(f32x4*)(op + 192) = kd; *(f32x4*)(op + 320) = vv; }
        if (MODE == 2) *(f32x4*)(op + 256) = rr;
    };
    auto ldstep = [&](const float* op) -> RwStep {
        RwStep x;
        x.w0 = *(const f32x4*)(op + c8 * 8); x.w1 = *(const f32x4*)(op + c8 * 8 + 4);
        x.a0 = *(const f32x4*)(op + 64 + c8 * 8); x.a1 = *(const f32x4*)(op + 64 + c8 * 8 + 4);
        x.b0 = *(const f32x4*)(op + 128 + c8 * 8); x.b1 = *(const f32x4*)(op + 128 + c8 * 8 + 4);
        if (MODE != 1) { x.k0 = *(const f32x4*)(op + 192 + c8 * 8); x.k1 = *(const f32x4*)(op + 192 + c8 * 8 + 4); x.v = op[320 + row]; }
        if (MODE == 2) { x.r0 = *(const f32x4*)(op + 256 + c8 * 8); x.r1 = *(const f32x4*)(op + 256 + c8 * 8 + 4); }
        return x;
    };
    const int q0 = seg * SEGQ;
    __syncthreads();
    prefetch(q0); stage(q0, 0);
    __syncthreads();
    for (int qi = 0; qi < SEGQ; ++qi) {
        const int q = q0 + qi, buf = qi & 1;
        if (qi + 1 < SEGQ) prefetch(q + 1);
        const float* ob = ops + (size_t)buf * 16 * 384;
        RwStep cur = ldstep(ob);
        float yv[16];
#pragma unroll
        for (int j = 0; j < 16; ++j) {
            RwStep nxt;
            if (j < 15) nxt = ldstep(ob + (j + 1) * 384);
            float sa = dot8(s0, s1, cur.a0, cur.a1);
            sa = row8_sum(sa);
            if (MODE != 1) { s0 = s0 * cur.w0 + (cur.b0 * sa + cur.k0 * cur.v); s1 = s1 * cur.w1 + (cur.b1 * sa + cur.k1 * cur.v); }
            else { s0 = s0 * cur.w0 + cur.b0 * sa; s1 = s1 * cur.w1 + cur.b1 * sa; }
            if (MODE == 2) {
                float y = dot8(s0, s1, cur.r0, cur.r1);
                yv[j] = row8_sum(y);
            }
            if (j < 15) cur = nxt;
        }
        if (MODE == 2 && c8 == 0) {
#pragma unroll
            for (int j = 0; j < 16; ++j) ybuf[(buf * 16 + j) * 32 + rowl] = yv[j];
        }
        if (qi + 1 < SEGQ) stage(q + 1, buf ^ 1);
        __syncthreads();
        if (MODE == 2) {
#pragma unroll
            for (int e = 0; e < 2; ++e) {
                const int idx = tid + 256 * e, j = idx >> 5, rw = idx & 31;
                Yout[(size_t)tok_of(q, j) * ystride + head * 64 + half * 32 + rw] = f2bf(ybuf[(buf * 16 + j) * 32 + rw]);
            }
        }
    }
    if (MODE != 2) {
        float* sp = RSEG + ((((size_t)MODE * 16 + hd) * NSEG + seg) * 64 + row) * 64 + c8 * 8;
        *(f32x4*)sp = s0; *(f32x4*)(sp + 4) = s1;
    }
    __syncthreads();
}
DI void rw_combine(const Params& P, int hd, unsigned char* smem) {
    float* S = (float*)smem;
    float* Pm = S + 4096;
    float* RSEG = (float*)(P.ws + WS_RSEG);
    const int tid = otid(), i = tid >> 2, nq = tid & 3;
    __syncthreads();
    for (int idx = tid; idx < 4096; idx += 256) S[idx] = 0.f;
    __syncthreads();
    for (int seg = 0; seg < NSEG; ++seg) {
        const float* Ls = RSEG + (((size_t)0 * 16 + hd) * NSEG + seg) * 4096;
        const float* Ps = RSEG + (((size_t)1 * 16 + hd) * NSEG + seg) * 4096;
        float* St = RSEG + (((size_t)2 * 16 + hd) * NSEG + seg) * 4096;
        for (int idx = tid; idx < 4096; idx += 256) { St[idx] = S[idx]; Pm[idx] = Ps[idx]; }
        __syncthreads();
        float acc[16];
#pragma unroll
        for (int n = 0; n < 16; ++n) acc[n] = Ls[i * 64 + nq * 16 + n];
        for (int m = 0; m < 64; ++m) {
            const float sv = S[i * 64 + m];
#pragma unroll
            for (int n = 0; n < 16; ++n) acc[n] += sv * Pm[m * 64 + nq * 16 + n];
        }
        __syncthreads();
#pragma unroll
        for (int n = 0; n < 16; ++n) S[i * 64 + nq * 16 + n] = acc[n];
        __syncthreads();
    }
}
DI void rw_passC(const Params& P, int l, int item, unsigned char* smem) {
    const int c = item >> 1, hf = item & 1;
    float* stat = (float*)smem;
    bf16* kx = (bf16*)(smem + 8192);
    bf16* gc = (bf16*)(smem + 25600);
    const int tid = otid(), lane = tid & 63, wave = tid >> 6, l15 = lane & 15, quad = lane >> 4;
    const bf16* Pm = (const bf16*)(P.ws + WS_RA);
    const bf16* WB = (const bf16*)(P.ws + WS_WB);
    bf16* YS = (bf16*)(P.ws + WS_RB); const bf16* RY = (const bf16*)(P.ws + WS_RY);
    __syncthreads();
    {
        const int c4 = tid & 15;
        for (int it = 0; it < 16; ++it) {
            const int pair = it * 16 + (tid >> 4), tok = pair >> 2, hh = pair & 3, head = hf * 4 + hh, t = c * 64 + tok, col = head * 64 + c4 * 4;
            float yf[4], yb[4], rr[4], kk[4];
            unpack4(*(const u32x2*)(YS + (size_t)t * 2048 + 1536 + col), yf); unpack4(*(const u32x2*)(RY + (size_t)t * 512 + col), yb);
            const f32x4 mu0 = *(const f32x4*)(P.in[27] + ((size_t)l * 3 + 0) * 512 + col), mu1 = *(const f32x4*)(P.in[27] + ((size_t)l * 3 + 1) * 512 + col);
            const f32x4 rk = *(const f32x4*)(P.in[38] + (size_t)l * 512 + col);
            float m0[4] = {mu0[0], mu0[1], mu0[2], mu0[3]}, m1[4] = {mu1[0], mu1[1], mu1[2], mu1[3]};
            rw_mix4(Pm, t, OFF_RR + col, m0, rr); rw_mix4(Pm, t, OFF_RK + col, m1, kk);
            float sy = 0.f, sy2 = 0.f, sb = 0.f;
#pragma unroll
            for (int r = 0; r < 4; ++r) { const float y = yf[r] + yb[r]; sy += y; sy2 += y * y; sb += rr[r] * kk[r] * rk[r]; }
            sy = row16_sum(sy); sy2 = row16_sum(sy2); sb = row16_sum(sb);
            const float mean = sy * (1.f / 64.f), var = fmaxf(sy2 * (1.f / 64.f) - mean * mean, 0.f);
            if (c4 == 0) *(f32x4*)(stat + (tok * 4 + hh) * 4) = (f32x4){mean, rsqrtf(var + 64e-5f), sb, 0.f};
        }
    }
    f32x4 ag[8];
#pragma unroll
    for (int i = 0; i < 8; ++i) ag[i] = (f32x4){0.f, 0.f, 0.f, 0.f};
    for (int kc = 0; kc < 4; ++kc) {
        __syncthreads();
        rw_build_chunk(P, l, c, 0, kc, kx);
        for (int idx = tid; idx < 128 * 16; idx += 256) {
            const int n = idx >> 4, k8 = idx & 15;
            *(u32x4*)(gc + n * 136 + k8 * 8) = *(const u32x4*)(WB + WB_RG1 + (size_t)n * 512 + kc * 128 + k8 * 8);
        }
        __syncthreads();
#pragma unroll
        for (int nt = 0; nt < 8; ++nt) ag[nt] = mma_rows<4>(kx + (wave * 16 + l15) * 136 + quad * 8, gc + (nt * 16 + l15) * 136 + quad * 8, ag[nt]);
    }
    __syncthreads();
    {
        const int tok = wave * 16 + l15;
#pragma unroll
        for (int nt = 0; nt < 8; ++nt) *(u32x2*)(kx + tok * 136 + nt * 16 + quad * 4) = pack4(sigm(ag[nt][0]), sigm(ag[nt][1]), sigm(ag[nt][2]), sigm(ag[nt][3]));
    }
    for (int nc = 2 * hf; nc < 2 * hf + 2; ++nc) {
        __syncthreads();
        for (int idx = tid; idx < 128 * 16; idx += 256) {
            const int n = idx >> 4, k8 = idx & 15;
            *(u32x4*)(gc + n * 136 + k8 * 8) = *(const u32x4*)(WB + WB_RG2 + ((size_t)nc * 128 + n) * 128 + k8 * 8);
        }
        __syncthreads();
        const int tok = wave * 16 + l15, t = c * 64 + tok;
#pragma unroll
        for (int nt = 0; nt < 8; ++nt) {
            const f32x4 g = mma_rows<4>(kx + tok * 136 + quad * 8, gc + (nt * 16 + l15) * 136 + quad * 8, (f32x4){0.f, 0.f, 0.f, 0.f});
            const int n = nc * 128 + nt * 16 + quad * 4, head = n >> 6;
            const f32x4 st = *(const f32x4*)(stat + (tok * 4 + (head & 3)) * 4);
            float yf[4], yb[4], vv[4];
            unpack4(*(const u32x2*)(YS + (size_t)t * 2048 + 1536 + n), yf); unpack4(*(const u32x2*)(RY + (size_t)t * 512 + n), yb);
            const f32x4 mu2 = *(const f32x4*)(P.in[27] + ((size_t)l * 3 + 2) * 512 + n);
            float m2[4] = {mu2[0], mu2[1], mu2[2], mu2[3]};
            rw_mix4(Pm, t, OFF_RV + n, m2, vv);
            const f32x4 lw = *(const f32x4*)(P.in[39] + (size_t)l * 512 + n), lb = *(const f32x4*)(P.in[40] + (size_t)l * 512 + n);
            float o[4];
#pragma unroll
            for (int r = 0; r < 4; ++r) o[r] = (((yf[r] + yb[r]) - st[0]) * st[1] * lw[r] + lb[r] + st[2] * vv[r]) * g[r];
            *(u32x2*)(YS + (size_t)t * 2048 + 1536 + n) = pack4(o[0], o[1], o[2], o[3]);
        }
    }
    __syncthreads();
}


#define NREP(k) ((DUPMASK >> (k)) & 1 ? 2 : 1)
#ifndef STOP_AT
#define STOP_AT 99
#endif
#ifndef DUMP_SEL
#define DUMP_SEL 0
#endif
DI void dbg_dump(const Params& P, const bf16* src, int stride, int col0, int ncols) {
    for (size_t i = (size_t)blockIdx.x * 256 + threadIdx.x; i < (size_t)SEQ * 1024; i += (size_t)gridDim.x * 256) {
        const int t = (int)(i >> 10), j = (int)(i & 1023);
        float v = 0.f;
        for (int c = j; c < ncols; c += 1024) v += bf2f(src[(size_t)t * stride + col0 + c]);
        P.out[i] = v;
    }
}

#if DUMP_SEL == 1
#define DBG_DUMP() dbg_dump(P, (const bf16*)(P.ws + WS_RB), 2048, 0, 2048)
#elif DUMP_SEL == 2
#define DBG_DUMP() dbg_dump(P, (const bf16*)(P.ws + WS_RA), 4608, 0, 4608)
#elif DUMP_SEL == 3
#define DBG_DUMP() dbg_dump(P, (const bf16*)(P.ws + WS_RB), 2048, 512, 512)
#elif DUMP_SEL == 4
#define DBG_DUMP() dbg_dump(P, (const bf16*)(P.ws + WS_RB), 2048, 1024, 512)
#elif DUMP_SEL == 5
#define DBG_DUMP() dbg_dump(P, (const bf16*)(P.ws + WS_RB), 2048, 1536, 512)
#elif DUMP_SEL == 6
#define DBG_DUMP() dbg_dump(P, (const bf16*)(P.ws + WS_YT), 512, 0, 512)
#elif DUMP_SEL == 7
#define DBG_DUMP() dbg_dump(P, (const bf16*)(P.ws + WS_RC), 1024, 0, 1024)
#else
#define DBG_DUMP() do {} while (0)
#endif
#define PHASE_END(id) do { GSYNC(); if ((id) == STOP_AT && l == 0) { DBG_DUMP(); return; } } while (0)

template <int N> struct IC { static constexpr int value = N; };
template <int NIL, class Body> DI int gemm_tiles(int bid, int G, int base, int N, bool ctx, Body body, bool latent = true) {
    const int ntL = N / (32 * NIL), ntC = N / 32, nL = latent ? 128 * ntL : 0, nAll = nL + (ctx ? 2 * ntC : 0);
    if (latent && G == 512 && base % 512 == 0 && (ntL % 8 == 0 || ntL % 8 == 4)) {
        const int x = bid & 7, j = bid >> 3, fc = ntL >> 3, nfull = 16 * fc, npatch = nfull + ((ntL & 7) ? 8 : 0);
        for (int p = x; p < npatch; p += 8) {
            int tm, tn;
            if (p < nfull) { tm = (p & 15) * 8 + (j >> 3); tn = (p >> 4) * 8 + (j & 7); }
            else { tm = (p - nfull) * 16 + (j >> 2); tn = fc * 8 + (j & 3); }
            body(IC<NIL>{}, 2 + tm, tn * 32 * NIL);
        }
        for (int t2 = bid; t2 < nAll - nL; t2 += G) body(IC<1>{}, t2 / ntC, (t2 % ntC) * 32);
        return base + ((nAll + 511) / 512) * 512;
    }
    int first = (bid - base) % G; if (first < 0) first += G;
    for (int tile = first; tile < nAll; tile += G) {
        if (tile < nL) body(IC<NIL>{}, 2 + tile / ntL, (tile % ntL) * 32 * NIL);
        else { const int t2 = tile - nL; body(IC<1>{}, t2 / ntC, (t2 % ntC) * 32); }
    }
    return base + nAll;
}
#define EPI_VARS(NI) const int tid = otid(), lane = tid & 63, wave = tid >> 6, l15 = lane & 15, quad = lane >> 4, wr = wave >> 1, wc = wave & 1; (void)tid
#define EPI_MN(NI) const int m = m0 + wr * 64 + mi * 16 + l15, n = n0 + wc * (16 * NI) + ni * 16 + quad * 4
__global__ void __launch_bounds__(NTHREADS, 2) fwd_megakernel(Params Parg) {
    extern __shared__ __attribute__((aligned(16))) unsigned char smem[];
    __shared__ uint4 xb_words;
    __shared__ unsigned qslot;
    const int bid = blockIdx.x, G = gridDim.x;
    if (threadIdx.x == 0) xb_words = make_uint4(0u, 0u, 0u, 0u);
    __syncthreads();
    XcdBarrier xb = xcd_barrier_post((unsigned*)(Parg.ws + WS_BAR), (volatile LAS unsigned*)&xb_words);
    Params* gp = (Params*)(Parg.ws + WS_BAR + 14336);
    if (threadIdx.x == 0) *gp = Parg;
    __threadfence();
    __syncthreads();
    if (Parg.out == nullptr) cg::this_grid().sync();
    const Params& P = *gp;

    float* MOD = (float*)(P.ws + WS_MOD);
    bf16* WB = (bf16*)(P.ws + WS_WB);
    bf16* H = (bf16*)(P.ws + WS_H);
    bf16* RA = (bf16*)(P.ws + WS_RA);
    bf16* YS = (bf16*)(P.ws + WS_RB);
    bf16* Z = (bf16*)(P.ws + WS_RC);
    bf16* A2 = (bf16*)(P.ws + WS_RC);
    bf16* YT = (bf16*)(P.ws + WS_YT);

    for (int it = bid; it < 384; it += G) mod_item(P, it, smem);
    conv_items(P, 0, bid, G, smem);
    GSYNC();
    { const int tid = otid(), lane = tid & 63, wave = tid >> 6, l15 = lane & 15, quad = lane >> 4; (void)tid; (void)l15; (void)quad;
    for (int r = bid * 4 + wave; r < T; r += G * 4) {
        const float* src = r < CTX ? P.in[2] + (size_t)r * D : P.in[0] + (size_t)(r - CTX) * D;
        const float* md = MOD + (size_t)(r < CTX ? 0 : 1) * 6144;
        ln_row(src, xrowp(P, r), nullptr, nullptr, md + 1024, md, H + (size_t)r * D, lane);
    } }
    GSYNC();

    for (int l = 0; l < DEPTH; ++l) {
        const float* modl = MOD + (size_t)l * 2 * 6144;
        const int tm0 = (l == DEPTH - 1) ? 2 : 0, ntm = 130 - tm0;
        for (int rep = 0; rep < NREP(0); ++rep)
            gemm_tiles<8>(bid, G, 0, WIN, true, [&](auto nic, int tm, int n0) {
                constexpr int NI = decltype(nic)::value; const int m0 = tm * 128;
                AccT<NI> acc; acc_zero(acc);
                gemm_k<NI>(acc, H + (size_t)m0 * D, D, WB + WB_WIN + (size_t)n0 * D, D, D, smem);
                EPI_VARS(NI);
#pragma unroll
                for (int mi = 0; mi < 4; ++mi)
#pragma unroll
                    for (int ni = 0; ni < NI; ++ni) { EPI_MN(NI);
                        *(u32x2*)(RA + (size_t)m * WIN + n) = pack4(acc.v[mi][ni][0], acc.v[mi][ni][1], acc.v[mi][ni][2], acc.v[mi][ni][3]); }
            });
        PHASE_END(1);
        {
            constexpr int N_RW = NT * 2, N_S5 = NT * 8, N_GL = NT * 8, N_LR = NT * 8, N_ALL = N_RW + N_S5 + N_GL + N_LR;
            unsigned* qctr = (unsigned*)(Parg.ws + WS_BAR + 15360) + 8 + l;
            for (;;) {
                __syncthreads();
                if (threadIdx.x == 0) qslot = __hip_atomic_fetch_add(qctr, 1u, __ATOMIC_RELAXED, __HIP_MEMORY_SCOPE_AGENT);
                __syncthreads();
                int r = (int)qslot;
                if (r >= N_ALL) break;
                if (r < N_RW) { PHX(0, rw_prep(P, l, r, smem)); continue; } r -= N_RW;
                if (r < N_GL) { PHX(1, gla_passA(P, l, r, smem)); continue; } r -= N_GL;
                if (r < N_LR) { PHX(2, lru_pass<0>(P, l, r, smem)); continue; } r -= N_LR;
                PHX(3, s5_passA(P, l, r, smem));
            }
        }
        PHASE_END(2);
        for (int rep = 0; rep < NREP(2); ++rep) for (int it = bid; it < 512; it += G) {
            if (it < 448) {
                const int mode = it / 224, u = it % 224, hd = u / 14, rem = u % 14, unit = ((hd * NSEG + (rem >> 1)) * 2 + (rem & 1));
                if (mode == 0) { PHX(4, rw_scan<0>(P, l, unit, smem)); } else { PHX(4, rw_scan<1>(P, l, unit, smem)); }
            } else if (rep == 0) {
                const int u = it - 448;
                PHX(5, gla_carry(P, u));
                if (u < 16) { PHX(6, s5_carry(P, l, u)); }
                else if (u < 20) { PHX(7, lru_carry(P, u - 16)); }
            }
        }
        xcd_barrier(xb);
        {
            for (int rep = 0; rep < NREP(2); ++rep) for (int it = bid; it < 256; it += G) { PHX(4, rw_scan<2>(P, l, it, smem)); }
            constexpr int N_S5 = NT * 8, N_GL = NT * 4, N_LR = NT * 8, N_Q = N_S5 + N_GL + N_LR;
            unsigned* qctr = (unsigned*)(Parg.ws + WS_BAR + 15360) + l;
            for (;;) {
                __syncthreads();
                if (threadIdx.x == 0) qslot = __hip_atomic_fetch_add(qctr, 1u, __ATOMIC_RELAXED, __HIP_MEMORY_SCOPE_AGENT);
                __syncthreads();
                int r = (int)qslot;
                if (r >= N_Q) break;
                if (r < N_GL) { PHX(10, gla_passC(P, l, r, smem)); continue; } r -= N_GL;
                if (r < N_S5) { PHX(9, s5_passC(P, l, r, smem)); continue; } r -= N_S5;
                PHX(11, lru_pass<1>(P, l, r, smem));
            }
        }
        PHASE_END(3);
        for (int it = bid + (tm0 ? 8 : 0); it < NT * 2; it += G) { PHX(8, rw_passC(P, l, it, smem)); }
        PHASE_END(4);
        for (int rep = 0; rep < ((DUPMASK & 0x10000) ? 2 : 1); ++rep) {
            const int nb = gemm_tiles<8>(bid, G, 0, 4096, tm0 == 0, [&](auto nic, int tm, int n0) {
                constexpr int NI = decltype(nic)::value; const int m0 = tm * 128;
                AccT<NI> acc; acc_zero(acc);
                gemm_k<NI>(acc, H + (size_t)m0 * D, D, WB + WB_WG + (size_t)n0 * D, D, D, smem);
                EPI_VARS(NI);
#pragma unroll
                for (int mi = 0; mi < 4; ++mi)
#pragma unroll
                    for (int ni = 0; ni < NI; ++ni) { EPI_MN(NI);
                        const f32x4 bg = *(const f32x4*)(P.in[43] + (size_t)l * 4096 + n);
                        *(u32x2*)(RA + (size_t)m * 4096 + n) = pack4(sigm(acc.v[mi][ni][0] + bg[0]), sigm(acc.v[mi][ni][1] + bg[1]), sigm(acc.v[mi][ni][2] + bg[2]), sigm(acc.v[mi][ni][3] + bg[3])); }
            });
            gemm_tiles<4>(bid, G, nb, 512, tm0 == 0, [&](auto nic, int tm, int n0) {
                constexpr int NI = decltype(nic)::value; const int m0 = tm * 128;
                AccT<NI> acc; acc_zero(acc);
                gemm_kloop<NI>(acc, YT + (size_t)m0 * 512, 512, WB + WB_GLU + (size_t)n0 * 512, 512, 512, smem);
                EPI_VARS(NI);
#pragma unroll
                for (int mi = 0; mi < 4; ++mi)
#pragma unroll
                    for (int ni = 0; ni < NI; ++ni) { EPI_MN(NI);
                        float y[4]; unpack4(*(const u32x2*)(YT + (size_t)m * 512 + n), y);
                        *(u32x2*)(YS + (size_t)m * 2048 + n) = pack4(y[0] * sigm(acc.v[mi][ni][0]), y[1] * sigm(acc.v[mi][ni][1]), y[2] * sigm(acc.v[mi][ni][2]), y[3] * sigm(acc.v[mi][ni][3])); }
            });
        }
        PHASE_END(5);
        for (int rep = 0; rep < ((DUPMASK & 0x4000) ? 2 : 1); ++rep)
            gemm_tiles<4>(bid, G, 0, D, tm0 == 0, [&](auto nic, int tm, int n0) {
                constexpr int NI = decltype(nic)::value; const int m0 = tm * 128;
                AccT<NI> zacc; acc_zero(zacc);
#pragma unroll 1
                for (int nb = 0; nb < 4; ++nb) {
                    AccT<NI> acc; acc_zero(acc);
                    if constexpr (NI == 4) gemm_kloopw<4>(acc, YS + (size_t)m0 * 2048 + nb * 512, 2048, WB + WB_WBR + (size_t)nb * 1024 * 512 + (size_t)n0 * 512, 512, 512, smem);
                    else gemm_kloop<NI>(acc, YS + (size_t)m0 * 2048 + nb * 512, 2048, WB + WB_WBR + (size_t)nb * 1024 * 512 + (size_t)n0 * 512, 512, 512, smem);
                    EPI_VARS(NI);
#pragma unroll
                    for (int mi = 0; mi < 4; ++mi)
#pragma unroll
                        for (int ni = 0; ni < NI; ++ni) { EPI_MN(NI);
                            float gt[4]; unpack4(*(const u32x2*)(RA + (size_t)m * 4096 + nb * 1024 + n), gt);
#pragma unroll
                            for (int r = 0; r < 4; ++r) zacc.v[mi][ni][r] += gt[r] * acc.v[mi][ni][r]; }
                }
                EPI_VARS(NI);
#pragma unroll
                for (int mi = 0; mi < 4; ++mi)
#pragma unroll
                    for (int ni = 0; ni < NI; ++ni) { EPI_MN(NI);
                        *(u32x2*)(Z + (size_t)m * D + n) = pack4(zacc.v[mi][ni][0], zacc.v[mi][ni][1], zacc.v[mi][ni][2], zacc.v[mi][ni][3]); }
            });
        PHASE_END(6);
        gemm_tiles<8>(bid, G, 0, D, tm0 == 0, [&](auto nic, int tm, int n0) {
            constexpr int NI = decltype(nic)::value; const int m0 = tm * 128;
            AccT<NI> acc; acc_zero(acc);
            gemm_k<NI>(acc, Z + (size_t)m0 * D, D, WB + WB_WOUT + (size_t)n0 * D, D, D, smem);
            EPI_VARS(NI);
            const float* md = modl + (size_t)(m0 < CTX ? 0 : 1) * 6144 + 2048;
#pragma unroll
            for (int mi = 0; mi < 4; ++mi)
#pragma unroll
                for (int ni = 0; ni < NI; ++ni) { EPI_MN(NI);
                    float* xp = xrowp(P, m) + n;
                    const f32x4 g = *(const f32x4*)(md + n), x = *(const f32x4*)xp;
                    *(f32x4*)xp = x * DN_ALPHA + g * acc.v[mi][ni]; }
        });
        PHASE_END(7);
        { const int tid = otid(), lane = tid & 63, wave = tid >> 6, l15 = lane & 15, quad = lane >> 4; (void)tid; (void)l15; (void)quad;
        for (int r = tm0 * 128 + bid * 4 + wave; r < T; r += G * 4) {
            const float* md = modl + (size_t)(r < CTX ? 0 : 1) * 6144;
            float* xp = xrowp(P, r);
            ln_row(xp, xp, P.in[45] + (size_t)l * D, P.in[46] + (size_t)l * D, md + 4096, md + 3072, H + (size_t)r * D, lane);
        } }
        PHASE_END(8);
        for (int rep = 0; rep < ((DUPMASK & 0x8000) ? 2 : 1); ++rep) {
            const int nb5 = gemm_tiles<4>(bid, G, 0, 2 * FF, false, [&](auto nic, int tm, int n0) {
                constexpr int NI = decltype(nic)::value;
                if constexpr (NI == 4) {
                    const int m0 = tm * 128, f0 = n0 >> 1;
                    AccT<4> acc; acc_zero(acc);
                    gemm_kloop<4, 1>(acc, H + (size_t)m0 * D, D, WB + WB_WUP + (size_t)f0 * D, D, D, smem);
                    EPI_VARS(4);
#pragma unroll
                    for (int ni = 0; ni < 2; ++ni) {
                        const int f = f0 + wc * 32 + ni * 16 + quad * 4;
                        const f32x4 cw0 = *(const f32x4*)(P.in[50] + ((size_t)l * 3 + 0) * FF + f), cw1 = *(const f32x4*)(P.in[50] + ((size_t)l * 3 + 1) * FF + f), cw2 = *(const f32x4*)(P.in[50] + ((size_t)l * 3 + 2) * FF + f);
                        const f32x4 cb = *(const f32x4*)(P.in[51] + (size_t)l * FF + f);
#pragma unroll
                        for (int mi = 0; mi < 4; ++mi) {
                            const int m = m0 + wr * 64 + mi * 16 + l15;
                            float o[4];
#pragma unroll
                            for (int r = 0; r < 4; ++r) {
                                const float uc = acc.v[mi][ni][r];
                                float up = __int_as_float(__builtin_amdgcn_update_dpp(0, __float_as_int(uc), 0x111, 0xF, 0xF, true));
                                float un = __int_as_float(__builtin_amdgcn_update_dpp(0, __float_as_int(uc), 0x101, 0xF, 0xF, true));
                                if (mi > 0) { const float w = __int_as_float(__builtin_amdgcn_update_dpp(0, __float_as_int(acc.v[mi > 0 ? mi - 1 : 0][ni][r]), 0x121, 0xF, 0xF, true)); up = (l15 == 0) ? w : up; }
                                if (mi < 3) { const float w = __int_as_float(__builtin_amdgcn_update_dpp(0, __float_as_int(acc.v[mi < 3 ? mi + 1 : 3][ni][r]), 0x12F, 0xF, 0xF, true)); un = (l15 == 15) ? w : un; }
                                const float y = cb[r] + cw0[r] * up + cw1[r] * uc + cw2[r] * un;
                                o[r] = gelu_t(y) * acc.v[mi][ni + 2][r];
                            }
                            *(u32x2*)(A2 + (size_t)m * FF + f) = pack4(o[0], o[1], o[2], o[3]);
                        }
                    }
                }
            });
            gemm_tiles<4>(bid, G, nb5, 2 * FF, tm0 == 0, [&](auto nic, int tm, int n0) {
                constexpr int NI = decltype(nic)::value; const int m0 = tm * 128;
                AccT<NI> acc; acc_zero(acc);
                gemm_kloop<NI>(acc, H + (size_t)m0 * D, D, WB + WB_WUP + (size_t)n0 * D, D, D, smem);
                EPI_VARS(NI);
#pragma unroll
                for (int mi = 0; mi < 4; ++mi)
#pragma unroll
                    for (int ni = 0; ni < NI; ++ni) { EPI_MN(NI);
                        *(u32x2*)(RA + (size_t)m * 5632 + n) = pack4(acc.v[mi][ni][0], acc.v[mi][ni][1], acc.v[mi][ni][2], acc.v[mi][ni][3]); }
            }, false);
        }
        PHASE_END(9);
        for (int rep = 0; rep < ((DUPMASK & 0x1000) ? 2 : 1); ++rep) for (size_t idx = (size_t)tm0 * 128 * 352 + (size_t)bid * 256 + otid(); idx < (size_t)CTX * 352; idx += (size_t)G * 256) {
            const int t = (int)(idx / 352), f = (int)(idx % 352) * 8;
            const int seglo = t < CTX ? 0 : (t & ~63), seghi = t < CTX ? CTX : seglo + 64;
            const bf16* u0 = RA + (size_t)t * 5632 + f;
            const u32x4 uc = *(const u32x4*)u0, vv = *(const u32x4*)(u0 + FF);
            u32x4 um = (u32x4){0u, 0u, 0u, 0u}, up = (u32x4){0u, 0u, 0u, 0u};
            if (t > seglo) um = *(const u32x4*)(u0 - 5632);
            if (t + 1 < seghi) up = *(const u32x4*)(u0 + 5632);
            const float* cw = P.in[50] + (size_t)l * 3 * FF + f; const float* cbp = P.in[51] + (size_t)l * FF + f;
            u32x4 o;
#pragma unroll
            for (int i = 0; i < 4; ++i) {
                const float y0 = cbp[2 * i] + cw[2 * i] * bflo(um[i]) + cw[FF + 2 * i] * bflo(uc[i]) + cw[2 * FF + 2 * i] * bflo(up[i]);
                const float y1 = cbp[2 * i + 1] + cw[2 * i + 1] * bfhi(um[i]) + cw[FF + 2 * i + 1] * bfhi(uc[i]) + cw[2 * FF + 2 * i + 1] * bfhi(up[i]);
                o[i] = pk2(gelu_t(y0) * bflo(vv[i]), gelu_t(y1) * bfhi(vv[i]));
            }
            *(u32x4*)(A2 + (size_t)t * FF + f) = o;
        }
        PHASE_END(10);
        gemm_tiles<8>(bid, G, 0, D, tm0 == 0, [&](auto nic, int tm, int n0) {
            constexpr int NI = decltype(nic)::value; const int m0 = tm * 128;
            AccT<NI> acc; acc_zero(acc);
            gemm_k<NI>(acc, A2 + (size_t)m0 * FF, FF, WB + WB_WDN + (size_t)n0 * FF, FF, FF, smem);
            EPI_VARS(NI);
            const float* md = modl + (size_t)(m0 < CTX ? 0 : 1) * 6144 + 5120;
#pragma unroll
            for (int mi = 0; mi < 4; ++mi)
#pragma unroll
                for (int ni = 0; ni < NI; ++ni) { EPI_MN(NI);
                    float* xp = xrowp(P, m) + n;
                    const f32x4 g = *(const f32x4*)(md + n), x = *(const f32x4*)xp;
                    *(f32x4*)xp = x * DN_ALPHA + g * acc.v[mi][ni]; }
        });
        PHASE_END(11);
        {
            const float* modn = MOD + (size_t)(l + 1 < DEPTH ? l + 1 : l) * 2 * 6144;
            const int tid = otid(), lane = tid & 63, wave = tid >> 6, l15 = lane & 15, quad = lane >> 4; (void)tid; (void)l15; (void)quad;
            for (int r = tm0 * 128 + bid * 4 + wave; r < T; r += G * 4) {
                const float* md = modn + (size_t)(r < CTX ? 0 : 1) * 6144;
                float* xp = xrowp(P, r);
                if (l + 1 < DEPTH) ln_row(xp, xp, P.in[47] + (size_t)l * D, P.in[48] + (size_t)l * D, md + 1024, md, H + (size_t)r * D, lane);
                else ln_row<true>(xp, xp, P.in[47] + (size_t)l * D, P.in[48] + (size_t)l * D, md + 1024, md, nullptr, lane);
            }
            for (int rep = 0; rep < ((DUPMASK & 0x2000) ? 2 : 1); ++rep) if (l + 1 < DEPTH) conv_items(P, l + 1, bid, G, smem);
        }
        if (l + 1 < DEPTH) GSYNC();
    }
}

extern "C" void kernel_launch(void* const* d_in, const int* in_sizes, int n_in, void* d_out, int out_size, void* d_ws, size_t ws_size, hipStream_t stream) {
    static int grid_blocks = 0;
    if (!grid_blocks) {
        if (n_in != 53 || ws_size < WS_END) { fprintf(stderr, "kernel_launch: unexpected n_in %d or ws_size %zu (< %zu)\n", n_in, ws_size, (size_t)WS_END); }
        int dev = 0, cus = 0, per_cu = 0;
        hipGetDevice(&dev);
        hipDeviceGetAttribute(&cus, hipDeviceAttributeMultiprocessorCount, dev);
        hipFuncSetAttribute((const void*)fwd_megakernel, hipFuncAttributeMaxDynamicSharedMemorySize, LDS_BYTES);
        hipOccupancyMaxActiveBlocksPerMultiprocessor(&per_cu, (const void*)fwd_megakernel, NTHREADS, LDS_BYTES);
        if (per_cu > 2) per_cu = 2;
        if (per_cu < 1) per_cu = 1;
        grid_blocks = cus * per_cu;
    }
    hipMemsetAsync((char*)d_ws + WS_BAR, 0, 16384, stream);
    Params p{};
    for (int i = 0; i < 53; ++i) p.in[i] = (const float*)d_in[i];
    p.out = (float*)d_out; p.ws = (unsigned char*)d_ws;
    void* args[] = {&p};
    hipError_t e = hipLaunchCooperativeKernel((const void*)fwd_megakernel, dim3(grid_blocks), dim3(NTHREADS), args, LDS_BYTES, stream);
    if (e != hipSuccess) fprintf(stderr, "cooperative launch failed: %s (grid %d)\n", hipGetErrorString(e), grid_blocks);
}
```

```cpp
#include <hip/hip_runtime.h>
#include <hip/hip_cooperative_groups.h>
#include <cstdio>
#include <cstdint>
namespace cg = cooperative_groups;

#define DI __device__ __forceinline__
#ifndef DUPMASK
#define DUPMASK 0
#endif
#define GSYNC() do { xcd_barrier(xb); if (DUPMASK & 0x800) xcd_barrier(xb); } while (0)
#ifndef PHMASK
#define PHMASK 0xFFFFFFFFu
#endif
#define PHX(k, stmt) do { if (PHMASK & (1u << (k))) { stmt; } } while (0)
#define LAS __attribute__((address_space(3)))
typedef unsigned short bf16;
typedef _Float16 f16;
typedef short bf16x8 __attribute__((ext_vector_type(8)));
typedef float f32x4 __attribute__((ext_vector_type(4)));
typedef float f32x2 __attribute__((ext_vector_type(2)));
typedef unsigned u32x4 __attribute__((ext_vector_type(4)));
typedef unsigned u32x2 __attribute__((ext_vector_type(2)));
typedef _Float16 f16x4 __attribute__((ext_vector_type(4)));

constexpr int D = 1024, CTX = 256, SEQ = 16384, T = CTX + SEQ, NT = T / 64, DEPTH = 4;
constexpr int WIN = 4608, FF = 2816;
constexpr int OFF_S5U = 0, OFF_GQ = 512, OFF_GK = 768, OFF_GV = 1024, OFF_GG = 1536, OFF_LX = 2048, OFF_LG = 2560, OFF_RR = 3072, OFF_RK = 3584, OFF_RV = 4096;
constexpr float DN_ALPHA = 1.6817928305074290f;
constexpr int LDS_BYTES = 73728;
constexpr int NTHREADS = 256;

constexpr size_t al256(size_t x) { return (x + 255) & ~(size_t)255; }
constexpr size_t WS_BAR = 0;
constexpr size_t WS_MOD = 16384;
constexpr size_t WS_XC = al256(WS_MOD + (size_t)4 * 2 * 6144 * 4);
constexpr size_t WS_WB = al256(WS_XC + (size_t)256 * 1024 * 4);
constexpr size_t WB_WIN = 0;
constexpr size_t WB_WG = WB_WIN + (size_t)4608 * 1024;
constexpr size_t WB_WBR = WB_WG + (size_t)4096 * 1024;
constexpr size_t WB_WOUT = WB_WBR + (size_t)4 * 1024 * 512;
constexpr size_t WB_WUP = WB_WOUT + (size_t)1024 * 1024;
constexpr size_t WB_WDN = WB_WUP + (size_t)5632 * 1024;
constexpr size_t WB_GLU = WB_WDN + (size_t)1024 * 2816;
constexpr size_t WB_RW1 = WB_GLU + (size_t)512 * 512;
constexpr size_t WB_RA1 = WB_RW1 + (size_t)2 * 64 * 512;
constexpr size_t WB_RW2 = WB_RA1 + (size_t)2 * 64 * 512;
constexpr size_t WB_RA2 = WB_RW2 + (size_t)2 * 512 * 64;
constexpr size_t WB_RG1 = WB_RA2 + (size_t)2 * 512 * 64;
constexpr size_t WB_RG2 = WB_RG1 + (size_t)128 * 512;
constexpr size_t WB_LWA = WB_RG2 + (size_t)512 * 128;
constexpr size_t WB_LWX = WB_LWA + (size_t)64 * 1024;
constexpr size_t WB_END = WB_LWX + (size_t)64 * 1024;
constexpr size_t WS_H = al256(WS_WB + WB_END * 2);
constexpr size_t WS_RA = al256(WS_H + (size_t)T * 1024 * 2);
constexpr size_t WS_RB = al256(WS_RA + (size_t)T * 4608 * 2);
constexpr size_t WS_RC = al256(WS_RB + (size_t)T * 2048 * 2);
constexpr size_t WS_RW = al256(WS_RC + (size_t)T * 1024 * 2);
constexpr size_t WS_RY = al256(WS_RW + (size_t)4 * T * 512 * 2);
constexpr size_t WS_YT = al256(WS_RY + (size_t)T * 512 * 2);
constexpr size_t WS_S5E = al256(WS_YT + (size_t)T * 512 * 2);
constexpr size_t WS_GDEC = al256(WS_S5E + (size_t)NT * 2 * 32 * 64 * 2 * 4);
constexpr size_t WS_LA = al256(WS_GDEC + (size_t)NT * 2 * 4 * 64 * 4);
constexpr size_t WS_LB = al256(WS_LA + (size_t)NT * 2 * 512 * 4);
constexpr size_t WS_RSEG = al256(WS_LB + (size_t)NT * 2 * 512 * 4);
constexpr size_t WS_GBS = al256(WS_RSEG + (size_t)3 * 16 * 8 * 4096 * 4);
constexpr size_t WS_END = al256(WS_GBS + (size_t)NT * 2 * 4 * 4096 * 4);
static_assert(WS_RC + (size_t)T * 2816 * 2 <= WS_RY, "A2 alias");
static_assert(WS_RA + (size_t)T * 5632 * 2 <= WS_RC, "UV alias");

struct Params {
    const float* in[53];
    float* out;
    unsigned char* ws;
};

typedef __bf16 bf16x2_t __attribute__((ext_vector_type(2)));
DI unsigned pk2(float lo, float hi) { bf16x2_t v; v[0] = (__bf16)lo; v[1] = (__bf16)hi; return __builtin_bit_cast(unsigned, v); }
DI bf16 f2bf(float x) { return (bf16)(pk2(x, 0.f) & 0xffffu); }
DI float bf2f(bf16 h) { return __uint_as_float(((unsigned)h) << 16); }
DI float bflo(unsigned u) { return __uint_as_float(u << 16); }
DI float bfhi(unsigned u) { return __uint_as_float(u & 0xffff0000u); }
DI void unpack4(u32x2 v, float* o) { o[0] = bflo(v.x); o[1] = bfhi(v.x); o[2] = bflo(v.y); o[3] = bfhi(v.y); }
DI u32x2 pack4(float a, float b, float c, float d) { u32x2 r; r.x = pk2(a, b); r.y = pk2(c, d); return r; }
DI float sigm(float x) { return __builtin_amdgcn_rcpf(1.f + __expf(-x)); }
DI float gelu_t(float x) { const float u = 0.7978845608028654f * (x + 0.044715f * x * x * x); return x * sigm(2.f * u); }
DI float silu_(float x) { return x * sigm(x); }
DI float softplus_(float x) { return fmaxf(x, 0.f) + __logf(1.f + __expf(-fabsf(x))); }
DI float tanh_(float x) { return 1.f - 2.f * __builtin_amdgcn_rcpf(__expf(2.f * x) + 1.f); }
DI int otid() { int t = threadIdx.x; asm volatile("" : "+v"(t)); return t; }
DI f32x4 mfma16(bf16x8 a, bf16x8 b, f32x4 c) { return __builtin_amdgcn_mfma_f32_16x16x32_bf16(a, b, c, 0, 0, 0); }
DI int tile_at(int d, int o) { return d == 0 ? o : (o < 4 ? 3 - o : 263 - o); }
DI int order_of(int d, int c) { return d == 0 ? c : (c < 4 ? 3 - c : 263 - c); }
DI float* xrowp(const Params& P, int t) { return t < CTX ? (float*)(P.ws + WS_XC) + (size_t)t * D : P.out + (size_t)(t - CTX) * D; }

template <int CTRL> DI float dpp_add(float x) {
    const int y = __builtin_amdgcn_update_dpp(0, __float_as_int(x), CTRL, 0xF, 0xF, true);
    return x + __int_as_float(y);
}
DI float row16_sum(float x) {
    x = dpp_add<0xB1>(x); x = dpp_add<0x4E>(x); x = dpp_add<0x141>(x); x = dpp_add<0x140>(x); return x;
}
DI float wave_sum(float v) {
#pragma unroll
    for (int o = 1; o < 64; o <<= 1) v += __shfl_xor(v, o);
    return v;
}

#define XB_TMO      128
#define XB_XCNT(j)  (256  + 64 * (j))
#define XB_XSUB(j)  (1280 + 64 * (j))
#define XB_XGEN(j)  (2304 + 64 * (j))
#define XB_TOP      3328
#define XB_TOPGEN   3392
#define XCD_BAR_WORDS 3456
#define XB_SPIN_CAP (1u << 23)
DI unsigned xb_ld(unsigned* p) { return __hip_atomic_load(p, __ATOMIC_RELAXED, __HIP_MEMORY_SCOPE_AGENT); }
DI unsigned xb_add(unsigned* p, unsigned v) { return __hip_atomic_fetch_add(p, v, __ATOMIC_RELAXED, __HIP_MEMORY_SCOPE_AGENT); }
DI unsigned xb_xcc_id() { return (unsigned)__builtin_amdgcn_s_getreg((3 << 11) | 20) & 0xFu; }
#define XB_SPIN(cond, bar) do { unsigned _sp = 0; while (cond) { __builtin_amdgcn_s_sleep(1); \
    if ((++_sp & 255u) == 0u) { if (xb_ld(&(bar)[XB_TMO])) break; if (_sp > XB_SPIN_CAP) { atomicAdd(&(bar)[XB_TMO], 1u); break; } } } } while (0)
struct XcdBarrier { unsigned* bar; unsigned x; volatile LAS unsigned* st; };
DI XcdBarrier xcd_barrier_post(unsigned* bar, volatile LAS unsigned* st) {
    XcdBarrier b; b.bar = bar; b.x = xb_xcc_id(); b.st = st;
    if (threadIdx.x == 0) (void)xb_add(&bar[XB_XCNT(b.x)], 1u);
    return b;
}
DI void xcd_barrier_complete(unsigned* bar, unsigned x, unsigned& nloc, unsigned& nx) {
    const unsigned G = gridDim.x * gridDim.y * gridDim.z;
    unsigned sum, cnt, mine, sp = 0u;
    for (;;) {
        sum = 0u; cnt = 0u; mine = 0u;
#pragma unroll
        for (unsigned j = 0; j < 16; ++j) { const unsigned c = xb_ld(&bar[XB_XCNT(j)]); sum += c; cnt += (c > 0u) ? 1u : 0u; mine = (j == x) ? c : mine; }
        if (sum == G) break;
        __builtin_amdgcn_s_sleep(1);
        if ((++sp & 255u) == 0u) { if (xb_ld(&bar[XB_TMO])) break; if (sp > XB_SPIN_CAP) { atomicAdd(&bar[XB_TMO], 1u); break; } }
    }
    nloc = mine > 0u ? mine : 1u; nx = cnt > 0u ? cnt : 1u;
}
DI void xcd_barrier(const XcdBarrier& b) {
    asm volatile("s_waitcnt vmcnt(0)" ::: "memory");
    __syncthreads();
    if (threadIdx.x == 0) {
        unsigned* bar = b.bar;
        __builtin_amdgcn_s_waitcnt(0);
        unsigned nloc = b.st[0], nx = b.st[1];
        if (nloc == 0u) { xcd_barrier_complete(bar, b.x, nloc, nx); b.st[0] = nloc; b.st[1] = nx; }
        const unsigned old = xb_add(&bar[XB_XSUB(b.x)], 1u);
        const unsigned gen = old / nloc;
        if (old + 1u == (gen + 1u) * nloc) {
            __builtin_amdgcn_fence(__ATOMIC_RELEASE, "agent");
            asm volatile("s_waitcnt vmcnt(0)" ::: "memory");
            const unsigned og = xb_add(&bar[XB_TOP], 1u);
            const unsigned tg = og / nx;
            if (og + 1u == (tg + 1u) * nx) xb_add(&bar[XB_TOPGEN], 1u);
            else XB_SPIN(xb_ld(&bar[XB_TOPGEN]) == tg, bar);
            __builtin_amdgcn_fence(__ATOMIC_ACQUIRE, "agent");
            xb_add(&bar[XB_XGEN(b.x)], 1u);
            asm volatile("s_waitcnt vmcnt(0)" ::: "memory");
        } else {
            XB_SPIN(xb_ld(&bar[XB_XGEN(b.x)]) == gen, bar);
            __builtin_amdgcn_fence(__ATOMIC_ACQUIRE, "agent");
            asm volatile("s_waitcnt vmcnt(0)" ::: "memory");
        }
    }
    __syncthreads();
}

template <int NI> struct AccT { f32x4 v[4][NI]; };
typedef AccT<4> Acc;
template <int NI> DI void acc_zero(AccT<NI>& a) {
    float z = 0.f; asm volatile("" : "+v"(z));
#pragma unroll
    for (int i = 0; i < 4; ++i)
#pragma unroll
        for (int j = 0; j < NI; ++j) a.v[i][j] = (f32x4){z, z, z, z};
}
template <int NI> DI void gemm_kloop1(AccT<NI>& acc, const bf16* __restrict__ A, int lda, const bf16* __restrict__ B, int ldb, int K, unsigned char* smem) {
    bf16* sA = (bf16*)smem;
    bf16* sB = (bf16*)(smem + 32768);
    constexpr int NB = NI;
    constexpr int BSUB = 32 * NI * 32, BBUF = 2 * BSUB;
    const int tid = otid(), lane = tid & 63, wave = tid >> 6, wr = wave >> 1, wc = wave & 1, l15 = lane & 15, quad = lane >> 4;
    const int KT = K / 64;
    u32x4 ra[4], rb[NB];
    const int kq = tid & 7, row0 = tid >> 3;
    const bf16* ga = A + (size_t)row0 * lda + kq * 8;
    const bf16* gb = B + (size_t)row0 * ldb + kq * 8;
    const int loA = (kq >> 2) * 4096 + row0 * 32 + (kq & 3) * 8;
    const int loB = (kq >> 2) * BSUB + row0 * 32 + (kq & 3) * 8;
#pragma unroll
    for (int i = 0; i < 4; ++i) ra[i] = *(const u32x4*)(ga + (size_t)(32 * i) * lda);
#pragma unroll
    for (int i = 0; i < NB; ++i) rb[i] = *(const u32x4*)(gb + (size_t)(32 * i) * ldb);
#pragma unroll
    for (int i = 0; i < 4; ++i) *(u32x4*)(sA + loA + i * 1024) = ra[i];
#pragma unroll
    for (int i = 0; i < NB; ++i) *(u32x4*)(sB + loB + i * 1024) = rb[i];
    __syncthreads();
#pragma unroll 1
    for (int kt = 0; kt < KT; ++kt) {
        const int cur = kt & 1;
        if (kt + 1 < KT) {
#pragma unroll
            for (int i = 0; i < 4; ++i) ra[i] = *(const u32x4*)(ga + (size_t)(32 * i) * lda + (kt + 1) * 64);
#pragma unroll
            for (int i = 0; i < NB; ++i) rb[i] = *(const u32x4*)(gb + (size_t)(32 * i) * ldb + (kt + 1) * 64);
        }
        const bf16* cA = sA + cur * 8192 + (wr * 64 + l15) * 32 + quad * 8;
        const bf16* cB = sB + cur * BBUF + (wc * 16 * NI + l15) * 32 + quad * 8;
#pragma unroll
        for (int sub = 0; sub < 2; ++sub) {
            bf16x8 xf[4], wf[NI];
#pragma unroll
            for (int i = 0; i < 4; ++i) xf[i] = *(const bf16x8*)(cA + sub * 4096 + i * 512);
#pragma unroll
            for (int i = 0; i < NI; ++i) wf[i] = *(const bf16x8*)(cB + sub * BSUB + i * 512);
#pragma unroll
            for (int mi = 0; mi < 4; ++mi)
#pragma unroll
                for (int ni = 0; ni < NI; ++ni) acc.v[mi][ni] = mfma16(wf[ni], xf[mi], acc.v[mi][ni]);
        }
        if (kt + 1 < KT) {
            const int nx = cur ^ 1;
#pragma unroll
            for (int i = 0; i < 4; ++i) *(u32x4*)(sA + nx * 8192 + loA + i * 1024) = ra[i];
#pragma unroll
            for (int i = 0; i < NB; ++i) *(u32x4*)(sB + nx * BBUF + loB + i * 1024) = rb[i];
        }
        __syncthreads();
    }
}

template <int NI, int BMAP = 0> DI void gemm_kloop(AccT<NI>& acc, const bf16* __restrict__ A, int lda, const bf16* __restrict__ B, int ldb, int K, unsigned char* smem) {
    bf16* sA = (bf16*)smem;
    bf16* sB = (bf16*)(smem + 32768);
    constexpr int NB = NI;
    constexpr int BSUB = 32 * NI * 32, BBUF = 2 * BSUB;
    const int tid = otid(), lane = tid & 63, wave = tid >> 6, wr = wave >> 1, wc = wave & 1, l15 = lane & 15, quad = lane >> 4;
    const int KT = K / 64;
    u32x4 ra0[4], rb0[NB], ra1[4], rb1[NB];
    const int kq = tid & 7, row0 = tid >> 3;
    const bf16* ga = A + (size_t)row0 * lda + kq * 8;
    const bf16* gb = B + (size_t)row0 * ldb + kq * 8;
    const int kqs = (kq & 3) ^ (((row0 >> 3) & 1) << 1);
    const int loA = (kq >> 2) * 4096 + row0 * 32 + kqs * 8;
    const int loB = (kq >> 2) * BSUB + row0 * 32 + kqs * 8;
    const int qs = quad ^ (((l15 >> 3) & 1) << 1);
    const bf16* cA0 = sA + (wr * 64 + l15) * 32 + qs * 8;
    const bf16* cB0 = sB + (wc * 16 * NI + l15) * 32 + qs * 8;
#define G_LOAD(RA, RB, KTI) do { _Pragma("unroll") for (int i = 0; i < 4; ++i) RA[i] = *(const u32x4*)(ga + (size_t)(32 * i) * lda + (KTI) * 64); \
                                 _Pragma("unroll") for (int i = 0; i < NB; ++i) RB[i] = *(const u32x4*)(gb + (size_t)(BMAP ? ((i & 1) * FF + (i >> 1) * 32) : 32 * i) * ldb + (KTI) * 64); } while (0)
#define G_STORE(RA, RB, BUF) do { _Pragma("unroll") for (int i = 0; i < 4; ++i) *(u32x4*)(sA + (BUF) * 8192 + loA + i * 1024) = RA[i]; \
                                  _Pragma("unroll") for (int i = 0; i < NB; ++i) *(u32x4*)(sB + (BUF) * BBUF + loB + i * 1024) = RB[i]; } while (0)
#define G_COMPUTE(BUF) do { _Pragma("unroll") for (int sub = 0; sub < 2; ++sub) { bf16x8 xf[4], wf[NI]; \
        _Pragma("unroll") for (int i = 0; i < 4; ++i) xf[i] = *(const bf16x8*)(cA0 + (BUF) * 8192 + sub * 4096 + i * 512); \
        _Pragma("unroll") for (int i = 0; i < NI; ++i) wf[i] = *(const bf16x8*)(cB0 + (BUF) * BBUF + sub * BSUB + i * 512); \
        _Pragma("unroll") for (int mi = 0; mi < 4; ++mi) _Pragma("unroll") for (int ni = 0; ni < NI; ++ni) acc.v[mi][ni] = mfma16(wf[ni], xf[mi], acc.v[mi][ni]); } } while (0)
    G_LOAD(ra0, rb0, 0);
    G_LOAD(ra1, rb1, 1);
    G_STORE(ra0, rb0, 0);
    __syncthreads();
#pragma unroll 1
    for (int kt = 0; kt < KT; kt += 2) {
        if (kt + 2 < KT) G_LOAD(ra0, rb0, kt + 2);
        G_COMPUTE(0);
        G_STORE(ra1, rb1, 1);
        __syncthreads();
        if (kt + 3 < KT) G_LOAD(ra1, rb1, kt + 3);
        G_COMPUTE(1);
        if (kt + 2 < KT) G_STORE(ra0, rb0, 0);
        __syncthreads();
    }
#undef G_LOAD
#undef G_STORE
#undef G_COMPUTE
}

template <int NI> DI void gemm_kloopw(AccT<NI>& acc, const bf16* __restrict__ A, int lda, const bf16* __restrict__ B, int ldb, int K, unsigned char* smem) {
    bf16* sA = (bf16*)smem;
    bf16* sB = (bf16*)(smem + 16384);
    constexpr int NBL = NI / 2, BBUF = 32 * NI * 32;
    const int tid = otid(), lane = tid & 63, wave = tid >> 6, wr = wave >> 1, wc = wave & 1, l15 = lane & 15, quad = lane >> 4;
    const int KT = K / 32;
    u32x4 ra[2], rb[NBL];
    const int kq = tid & 3, row0 = tid >> 2;
    const bf16* ga = A + (size_t)row0 * lda + kq * 8;
    const bf16* gb = B + (size_t)row0 * ldb + kq * 8;
    const int lo = row0 * 32 + (kq ^ (((row0 >> 3) & 1) << 1)) * 8;
    const int qs = quad ^ (((l15 >> 3) & 1) << 1);
    const bf16* cA0 = sA + (wr * 64 + l15) * 32 + qs * 8;
    const bf16* cB0 = sB + (wc * 16 * NI + l15) * 32 + qs * 8;
#pragma unroll
    for (int i = 0; i < 2; ++i) ra[i] = *(const u32x4*)(ga + (size_t)(64 * i) * lda);
#pragma unroll
    for (int i = 0; i < NBL; ++i) rb[i] = *(const u32x4*)(gb + (size_t)(64 * i) * ldb);
#pragma unroll
    for (int i = 0; i < 2; ++i) *(u32x4*)(sA + lo + i * 2048) = ra[i];
#pragma unroll
    for (int i = 0; i < NBL; ++i) *(u32x4*)(sB + lo + i * 2048) = rb[i];
    __syncthreads();
#pragma unroll 1
    for (int kt = 0; kt < KT; ++kt) {
        const int cur = kt & 1;
        if (kt + 1 < KT) {
#pragma unroll
            for (int i = 0; i < 2; ++i) ra[i] = *(const u32x4*)(ga + (size_t)(64 * i) * lda + (kt + 1) * 32);
#pragma unroll
            for (int i = 0; i < NBL; ++i) rb[i] = *(const u32x4*)(gb + (size_t)(64 * i) * ldb + (kt + 1) * 32);
        }
        {
            bf16x8 xf[4];
#pragma unroll
            for (int i = 0; i < 4; ++i) xf[i] = *(const bf16x8*)(cA0 + cur * 4096 + i * 512);
#pragma unroll
            for (int nh = 0; nh < NI / 4; ++nh) {
                bf16x8 wf[4];
#pragma unroll
                for (int i = 0; i < 4; ++i) wf[i] = *(const bf16x8*)(cB0 + cur * BBUF + (nh * 4 + i) * 512);
#pragma unroll
                for (int mi = 0; mi < 4; ++mi)
#pragma unroll
                    for (int ni = 0; ni < 4; ++ni) acc.v[mi][nh * 4 + ni] = mfma16(wf[ni], xf[mi], acc.v[mi][nh * 4 + ni]);
            }
        }
        if (kt + 1 < KT) {
            const int nx = cur ^ 1;
#pragma unroll
            for (int i = 0; i < 2; ++i) *(u32x4*)(sA + nx * 4096 + lo + i * 2048) = ra[i];
#pragma unroll
            for (int i = 0; i < NBL; ++i) *(u32x4*)(sB + nx * BBUF + lo + i * 2048) = rb[i];
        }
        __syncthreads();
    }
}

template <int NI> DI void gemm_k(AccT<NI>& acc, const bf16* A, int lda, const bf16* B, int ldb, int K, unsigned char* smem) {
    if constexpr (NI == 8) gemm_kloopw<8>(acc, A, lda, B, ldb, K, smem); else gemm_kloop<NI>(acc, A, lda, B, ldb, K, smem);
}
template <int KSTEPS> DI f32x4 mma_rows(const bf16* xrow, const bf16* wrow, f32x4 acc) {
#pragma unroll
    for (int s = 0; s < KSTEPS; ++s) acc = mfma16(*(const bf16x8*)(wrow + 32 * s), *(const bf16x8*)(xrow + 32 * s), acc);
    return acc;
}

DI void ln_row(const float* xin, float* xout, const float* g, const float* b, const float* sc, const float* sh, bf16* hout, int lane) {
    f32x4 v[4]; float s = 0.f;
#pragma unroll
    for (int j = 0; j < 4; ++j) { v[j] = *(const f32x4*)(xin + 4 * lane + 256 * j); s += (v[j][0] + v[j][1]) + (v[j][2] + v[j][3]); }
    const float mean = wave_sum(s) * (1.f / D); float s2 = 0.f;
#pragma unroll
    for (int j = 0; j < 4; ++j) { v[j] = v[j] - mean; s2 += (v[j][0] * v[j][0] + v[j][1] * v[j][1]) + (v[j][2] * v[j][2] + v[j][3] * v[j][3]); }
    const float rstd = rsqrtf(wave_sum(s2) * (1.f / D) + 1e-6f);
#pragma unroll
    for (int j = 0; j < 4; ++j) {
        const int c = 4 * lane + 256 * j;
        f32x4 y = v[j] * rstd;
        if (g) { const f32x4 gg = *(const f32x4*)(g + c), bb = *(const f32x4*)(b + c); y = y * gg + bb; }
        if (xout) *(f32x4*)(xout + c) = y;
        if (hout) { const f32x4 s1 = *(const f32x4*)(sc + c), s0 = *(const f32x4*)(sh + c); const f32x4 h = y * (s1 + 1.f) + s0; *(u32x2*)(hout + c) = pack4(h[0], h[1], h[2], h[3]); }
    }
}

struct ConvDesc { const float* src; bf16* dst; int K, N, ldk, ntile; };
DI void conv_tile(const ConvDesc& cd, int tile, unsigned char* smem) {
    float* s = (float*)smem;
    const int tid = otid();
    const int nb = cd.N / 64, kb = tile / nb, nbi = tile % nb, k0 = kb * 64, n0 = nbi * 64;
#pragma unroll
    for (int i = 0; i < 4; ++i) {
        const int r = (tid >> 4) + 16 * i, c4 = tid & 15;
        const f32x4 v = __builtin_nontemporal_load((const f32x4*)(cd.src + (size_t)(k0 + r) * cd.N + n0 + 4 * c4));
        s[r * 65 + 4 * c4 + 0] = v[0]; s[r * 65 + 4 * c4 + 1] = v[1]; s[r * 65 + 4 * c4 + 2] = v[2]; s[r * 65 + 4 * c4 + 3] = v[3];
    }
    __syncthreads();
    {
        const int n = tid >> 2, kq = tid & 3;
        float f[16];
#pragma unroll
        for (int i = 0; i < 16; ++i) f[i] = s[(16 * kq + i) * 65 + n];
        u32x4 o0, o1;
        o0[0] = pk2(f[0], f[1]); o0[1] = pk2(f[2], f[3]); o0[2] = pk2(f[4], f[5]); o0[3] = pk2(f[6], f[7]);
        o1[0] = pk2(f[8], f[9]); o1[1] = pk2(f[10], f[11]); o1[2] = pk2(f[12], f[13]); o1[3] = pk2(f[14], f[15]);
        bf16* d = cd.dst + (size_t)(n0 + n) * cd.ldk + k0 + 16 * kq;
        *(u32x4*)d = o0; *(u32x4*)(d + 8) = o1;
    }
    __syncthreads();
}
DI void conv_items(const Params& P, int l, int first, int stride, unsigned char* smem) {
    bf16* WB = (bf16*)(P.ws + WS_WB);
    int base = 0;
    __syncthreads();
    auto run = [&](const float* src, bf16* dst, int K, int N) {
        ConvDesc cd; cd.src = src; cd.dst = dst; cd.K = K; cd.N = N; cd.ldk = K; cd.ntile = (K / 64) * (N / 64);
        int f = (first - base) % stride; if (f < 0) f += stride;
        for (int tile = f; tile < cd.ntile; tile += stride) conv_tile(cd, tile, smem);
        base += cd.ntile;
    };
    run(P.in[6] + (size_t)l * 1024 * 4608, WB + WB_WIN, 1024, 4608);
    run(P.in[42] + (size_t)l * 1024 * 4096, WB + WB_WG, 1024, 4096);
#pragma unroll 1
    for (int b = 0; b < 4; ++b) run(P.in[41] + ((size_t)l * 4 + b) * 512 * 1024, WB + WB_WBR + (size_t)b * 1024 * 512, 512, 1024);
    run(P.in[44] + (size_t)l * 1024 * 1024, WB + WB_WOUT, 1024, 1024);
    run(P.in[49] + (size_t)l * 1024 * 5632, WB + WB_WUP, 1024, 5632);
    run(P.in[52] + (size_t)l * 2816 * 1024, WB + WB_WDN, 2816, 1024);
    run(P.in[15] + (size_t)l * 512 * 512, WB + WB_GLU, 512, 512);
#pragma unroll 1
    for (int d = 0; d < 2; ++d) {
        run(P.in[29] + ((size_t)l * 2 + d) * 512 * 64, WB + WB_RW1 + (size_t)d * 64 * 512, 512, 64);
        run(P.in[32] + ((size_t)l * 2 + d) * 512 * 64, WB + WB_RA1 + (size_t)d * 64 * 512, 512, 64);
        run(P.in[30] + ((size_t)l * 2 + d) * 64 * 512, WB + WB_RW2 + (size_t)d * 512 * 64, 64, 512);
        run(P.in[33] + ((size_t)l * 2 + d) * 64 * 512, WB + WB_RA2 + (size_t)d * 512 * 64, 64, 512);
    }
    run(P.in[34] + (size_t)l * 512 * 128, WB + WB_RG1, 512, 128);
    run(P.in[35] + (size_t)l * 128 * 512, WB + WB_RG2, 128, 512);
    run(P.in[22] + (size_t)l * 1024 * 64, WB + WB_LWA, 1024, 64);
    run(P.in[24] + (size_t)l * 1024 * 64, WB + WB_LWX, 1024, 64);
    __syncthreads();
}

DI void mod_item(const Params& P, int item, unsigned char* smem) {
    float* sv = (float*)smem;
    float* red = sv + 2048;
    const int tid = otid(), l = item / 96, n = (item % 96) * 64 + (tid & 63), ks = tid >> 6;
    __syncthreads();
    for (int i = tid; i < 1024; i += 256) { sv[i] = silu_(P.in[3][i]); sv[1024 + i] = silu_(P.in[1][i]); }
    __syncthreads();
    const float* w = P.in[4] + (size_t)l * 1024 * 6144 + n;
    float a0 = 0.f, a1 = 0.f;
#pragma unroll 8
    for (int k = ks * 256; k < ks * 256 + 256; ++k) { const float wv = __builtin_nontemporal_load(w + (size_t)k * 6144); a0 += sv[k] * wv; a1 += sv[1024 + k] * wv; }
    red[(ks * 64 + (tid & 63)) * 2] = a0; red[(ks * 64 + (tid & 63)) * 2 + 1] = a1;
    __syncthreads();
    if (tid < 128) {
        const int c = tid & 63, which = tid >> 6;
        float s = 0.f;
        for (int q = 0; q < 4; ++q) s += red[(q * 64 + c) * 2 + which];
        const int nn = (item % 96) * 64 + c;
        ((float*)(P.ws + WS_MOD))[((size_t)l * 2 + which) * 6144 + nn] = s + P.in[5][(size_t)l * 6144 + nn];
    }
    __syncthreads();
}

struct S5C { float ar[2], ai[2], fr[2], fi[2]; };
DI void s5_consts(const Params& P, int l, int g, int p, S5C& k) {
#pragma unroll
    for (int d = 0; d < 2; ++d) {
        const float dt = expf(P.in[9][((size_t)l * 2 + d) * 32 + g]);
        const float lr = P.in[7][(((size_t)l * 2 + d) * 32 + g) * 64 + p], li = P.in[8][(((size_t)l * 2 + d) * 32 + g) * 64 + p];
        const float mag = expf(lr * dt);
        k.ar[d] = mag * cosf(li * dt); k.ai[d] = mag * sinf(li * dt);
        const float nr = k.ar[d] - 1.f, ni = k.ai[d], den = lr * lr + li * li;
        k.fr[d] = (nr * lr + ni * li) / den; k.fi[d] = (ni * lr - nr * li) / den;
    }
}
DI void s5_load_u(const Params& P, int c, int gq, float* us) {
    const bf16* Pm = (const bf16*)(P.ws + WS_RA);
    for (int idx = otid(); idx < 64 * 16; idx += 256) {
        const int tok = idx >> 4, c4 = idx & 15;
        const u32x2 v = *(const u32x2*)(Pm + (size_t)(c * 64 + tok) * WIN + OFF_S5U + gq * 64 + c4 * 4);
        float f[4]; unpack4(v, f);
        *(f32x4*)(us + tok * 64 + c4 * 4) = (f32x4){f[0], f[1], f[2], f[3]};
    }
}
DI void s5_passA(const Params& P, int l, int item, unsigned char* smem) {
    float* us = (float*)smem;
    const int tid = otid(), c = item >> 3, gq = item & 7, gl = tid >> 6, p = tid & 63, g = gq * 4 + gl;
    __syncthreads();
    s5_load_u(P, c, gq, us);
    S5C k; s5_consts(P, l, g, p, k);
    float br[16], bi[16];
    {
        const float* b0 = P.in[10] + (((size_t)l * 32 + g) * 64 + p) * 16; const float* b1 = P.in[11] + (((size_t)l * 32 + g) * 64 + p) * 16;
#pragma unroll
        for (int h = 0; h < 16; ++h) { br[h] = b0[h]; bi[h] = b1[h]; }
    }
    __syncthreads();
    float efr = 0.f, efi = 0.f, ebr = 0.f, ebi = 0.f, pwr = 1.f, pwi = 0.f;
    for (int j = 0; j < 64; ++j) {
        const float* u = us + j * 64 + gl * 16;
        float rr = 0.f, ri = 0.f;
#pragma unroll
        for (int h = 0; h < 16; ++h) { rr += u[h] * br[h]; ri += u[h] * bi[h]; }
        const float bfr = k.fr[0] * rr - k.fi[0] * ri, bfi = k.fr[0] * ri + k.fi[0] * rr;
        const float nfr = k.ar[0] * efr - k.ai[0] * efi + bfr, nfi = k.ar[0] * efi + k.ai[0] * efr + bfi;
        efr = nfr; efi = nfi;
        const float bbr = k.fr[1] * rr - k.fi[1] * ri, bbi = k.fr[1] * ri + k.fi[1] * rr;
        ebr += pwr * bbr - pwi * bbi; ebi += pwr * bbi + pwi * bbr;
        const float npr = pwr * k.ar[1] - pwi * k.ai[1], npi = pwr * k.ai[1] + pwi * k.ar[1];
        pwr = npr; pwi = npi;
    }
    float* E = (float*)(P.ws + WS_S5E);
    *(float2*)(E + ((((size_t)c * 2 + 0) * 32 + g) * 64 + p) * 2) = make_float2(efr, efi);
    *(float2*)(E + ((((size_t)c * 2 + 1) * 32 + g) * 64 + p) * 2) = make_float2(ebr, ebi);
    __syncthreads();
}
DI void s5_carry(const Params& P, int l, int unit) {
    const int id = unit * 256 + otid(), d = id >> 11, g = (id >> 6) & 31, p = id & 63;
    S5C k; s5_consts(P, l, g, p, k);
    float Ar = d ? k.ar[1] : k.ar[0], Ai = d ? k.ai[1] : k.ai[0];
#pragma unroll
    for (int i = 0; i < 6; ++i) { const float nr = Ar * Ar - Ai * Ai, ni = 2.f * Ar * Ai; Ar = nr; Ai = ni; }
    float* E = (float*)(P.ws + WS_S5E);
    float hr = 0.f, hi = 0.f;
    for (int o0 = 0; o0 < NT; o0 += 13) {
        float2 e[13];
#pragma unroll
        for (int i = 0; i < 13; ++i) { const int c = tile_at(d, o0 + i); e[i] = *(const float2*)(E + ((((size_t)c * 2 + d) * 32 + g) * 64 + p) * 2); }
#pragma unroll
        for (int i = 0; i < 13; ++i) {
            const int c = tile_at(d, o0 + i);
            *(float2*)(E + ((((size_t)c * 2 + d) * 32 + g) * 64 + p) * 2) = make_float2(hr, hi);
            const float nr = Ar * hr - Ai * hi + e[i].x, ni = Ar * hi + Ai * hr + e[i].y;
            hr = nr; hi = ni;
        }
    }
}
DI void s5_passC(const Params& P, int l, int item, unsigned char* smem) {
    float* us = (float*)smem;
    bf16* hb = (bf16*)(smem + 16384);
    bf16* ct = (bf16*)(smem + 49664);
    const int tid = otid(), lane = tid & 63, wave = tid >> 6, l15 = lane & 15, quad = lane >> 4;
    const int c = item >> 3, gq = item & 7, gl = tid >> 6, p = tid & 63, g = gq * 4 + gl;
    __syncthreads();
    s5_load_u(P, c, gq, us);
    {
        const float* c0 = P.in[12] + ((size_t)l * 32 + gq * 4) * 16 * 64; const float* c1 = P.in[13] + ((size_t)l * 32 + gq * 4) * 16 * 64;
        for (int idx = tid; idx < 4096; idx += 256) { const int ch = idx >> 6, pp = idx & 63; ct[ch * 136 + pp] = f2bf(c0[idx]); ct[ch * 136 + 64 + pp] = f2bf(-c1[idx]); }
    }
    S5C k; s5_consts(P, l, g, p, k);
    float br[16], bi[16];
    {
        const float* b0 = P.in[10] + (((size_t)l * 32 + g) * 64 + p) * 16; const float* b1 = P.in[11] + (((size_t)l * 32 + g) * 64 + p) * 16;
#pragma unroll
        for (int h = 0; h < 16; ++h) { br[h] = b0[h]; bi[h] = b1[h]; }
    }
    const float* E = (const float*)(P.ws + WS_S5E);
    const float2 h0f = *(const float2*)(E + ((((size_t)c * 2 + 0) * 32 + g) * 64 + p) * 2);
    const float2 h0b = *(const float2*)(E + ((((size_t)c * 2 + 1) * 32 + g) * 64 + p) * 2);
    f32x4 yacc[4];
#pragma unroll
    for (int i = 0; i < 4; ++i) yacc[i] = (f32x4){0.f, 0.f, 0.f, 0.f};
#pragma unroll
    for (int d = 0; d < 2; ++d) {
        float hr = d ? h0b.x : h0f.x, hi = d ? h0b.y : h0f.y;
#pragma unroll
        for (int hs = 0; hs < 2; ++hs) {
            const int hf = d ? 1 - hs : hs;
            __syncthreads();
            for (int q = 0; q < 32; ++q) {
                const int jl = d ? 31 - q : q, j = hf * 32 + jl;
                const float* u = us + j * 64 + gl * 16;
                float rr = 0.f, ri = 0.f;
#pragma unroll
                for (int h = 0; h < 16; ++h) { rr += u[h] * br[h]; ri += u[h] * bi[h]; }
                const float bur = k.fr[d] * rr - k.fi[d] * ri, bui = k.fr[d] * ri + k.fi[d] * rr;
                const float nr = k.ar[d] * hr - k.ai[d] * hi + bur, ni = k.ar[d] * hi + k.ai[d] * hr + bui;
                hr = nr; hi = ni;
                hb[jl * 520 + gl * 128 + p] = f2bf(hr); hb[jl * 520 + gl * 128 + 64 + p] = f2bf(hi);
            }
            __syncthreads();
#pragma unroll
            for (int mt = 0; mt < 2; ++mt)
                yacc[hf * 2 + mt] = mma_rows<4>(hb + (mt * 16 + l15) * 520 + wave * 128 + quad * 8, ct + (wave * 16 + l15) * 136 + quad * 8, yacc[hf * 2 + mt]);
        }
    }
    bf16* YT = (bf16*)(P.ws + WS_YT);
    const f32x4 dsk = *(const f32x4*)(P.in[14] + (size_t)l * 512 + gq * 64 + wave * 16 + quad * 4);
#pragma unroll
    for (int mt = 0; mt < 4; ++mt) {
        const int tok = mt * 16 + l15;
        const f32x4 uu = *(const f32x4*)(us + tok * 64 + wave * 16 + quad * 4);
        *(u32x2*)(YT + (size_t)(c * 64 + tok) * 512 + gq * 64 + wave * 16 + quad * 4) =
            pack4(gelu_t(yacc[mt][0] + dsk[0] * uu[0]), gelu_t(yacc[mt][1] + dsk[1] * uu[1]), gelu_t(yacc[mt][2] + dsk[2] * uu[2]), gelu_t(yacc[mt][3] + dsk[3] * uu[3]));
    }
    __syncthreads();
}

template <int PASS> DI void lru_pass(const Params& P, int l, int item, unsigned char* smem) {
    float* xc = (float*)smem;
    float* xs = (float*)(smem + 16384);
    bf16* wt = (bf16*)(smem + 16384);
    float* al = (float*)(smem + 16384);
    float* bl = (float*)(smem + 32768);
    bf16* xcb = (bf16*)(smem + 53248);
    float* hsum = (float*)(smem + 53248);
    const int tid = otid(), lane = tid & 63, wave = tid >> 6, l15 = lane & 15, quad = lane >> 4;
    const int c = item >> 3, blk = item & 7, t0 = c * 64;
    const int seglo = c < 4 ? 0 : t0, seghi = c < 4 ? CTX : t0 + 64;
    const bf16* Pm = (const bf16*)(P.ws + WS_RA);
    const bf16* WB = (const bf16*)(P.ws + WS_WB);
    __syncthreads();
    for (int idx = tid; idx < 67 * 16; idx += 256) {
        const int r = idx >> 4, c4 = idx & 15, t = t0 - 2 + r;
        f32x4 v = (f32x4){0.f, 0.f, 0.f, 0.f};
        if (t >= seglo && t < seghi) { float f[4]; unpack4(*(const u32x2*)(Pm + (size_t)t * WIN + OFF_LX + blk * 64 + c4 * 4), f); v = (f32x4){f[0], f[1], f[2], f[3]}; }
        *(f32x4*)(xs + r * 64 + c4 * 4) = v;
    }
    __syncthreads();
    {
        const int chl = tid & 63, chg = blk * 64 + chl;
        const float w0 = P.in[20][((size_t)l * 4 + 0) * 512 + chg], w1 = P.in[20][((size_t)l * 4 + 1) * 512 + chg], w2 = P.in[20][((size_t)l * 4 + 2) * 512 + chg], w3 = P.in[20][((size_t)l * 4 + 3) * 512 + chg];
        const float cb = P.in[21][(size_t)l * 512 + chg];
        for (int tok = tid >> 6; tok < 64; tok += 4) {
            const float y = cb + w0 * xs[(tok + 0) * 64 + chl] + w1 * xs[(tok + 1) * 64 + chl] + w2 * xs[(tok + 2) * 64 + chl] + w3 * xs[(tok + 3) * 64 + chl];
            xc[tok * 64 + chl] = y; xcb[tok * 72 + chl] = f2bf(y);
        }
    }
    __syncthreads();
    for (int idx = tid; idx < 4 * 64 * 8; idx += 256) {
        const int q = idx >> 9, j = (idx >> 3) & 63, k8 = idx & 7, d = q >> 1;
        const bf16* src = WB + ((q & 1) ? WB_LWX : WB_LWA) + (size_t)j * 1024 + (d * 8 + blk) * 64 + k8 * 8;
        *(u32x4*)(wt + (q * 64 + j) * 72 + k8 * 8) = *(const u32x4*)src;
    }
    __syncthreads();
    f32x4 acc[16];
#pragma unroll
    for (int i = 0; i < 16; ++i) acc[i] = mma_rows<2>(xcb + (wave * 16 + l15) * 72 + quad * 8, wt + (i * 16 + l15) * 72 + quad * 8, (f32x4){0.f, 0.f, 0.f, 0.f});
    __syncthreads();
    const int tok = wave * 16 + l15;
    float* c8s = (float*)(smem + 69632);
    float* segp = (float*)(smem + 70144);
    float* segh = (float*)(smem + 71168);
    if (tid < 128) c8s[tid] = -8.f * softplus_(-P.in[26][((size_t)l * 2 + (tid >> 6)) * 512 + blk * 64 + (tid & 63)]);
    __syncthreads();
#pragma unroll
    for (int d = 0; d < 2; ++d) {
#pragma unroll
        for (int nt = 0; nt < 4; ++nt) {
            const int j0 = nt * 16 + quad * 4, chg = blk * 64 + j0;
            const f32x4 ba = *(const f32x4*)(P.in[23] + ((size_t)l * 2 + d) * 512 + chg), bx = *(const f32x4*)(P.in[25] + ((size_t)l * 2 + d) * 512 + chg);
            const f32x4 c8 = *(const f32x4*)(c8s + d * 64 + j0);
            const f32x4 xv = *(const f32x4*)(xc + tok * 64 + j0);
            f32x4 av, bv;
#pragma unroll
            for (int r = 0; r < 4; ++r) {
                const float rg = sigm(acc[(2 * d) * 4 + nt][r] + ba[r]), ig = sigm(acc[(2 * d + 1) * 4 + nt][r] + bx[r]);
                const float aa = __expf(c8[r] * rg);
                av[r] = aa; bv[r] = __builtin_amdgcn_sqrtf(fmaxf(1.f - aa * aa, 0.f)) * (ig * xv[r]);
            }
            *(f32x4*)(al + tok * 64 + j0) = av; *(f32x4*)(bl + tok * 64 + j0) = bv;
        }
        __syncthreads();
        {
            const int ch = lane, chg = blk * 64 + ch, part = wave;
            float* LA = (float*)(P.ws + WS_LA); float* LB = (float*)(P.ws + WS_LB);
            float ar[16], br_[16];
            float h = 0.f, ap = 1.f;
#pragma unroll
            for (int q = 0; q < 16; ++q) { const int pos = part * 16 + q, tk = d ? 63 - pos : pos; ar[q] = al[tk * 64 + ch]; br_[q] = bl[tk * 64 + ch]; }
#pragma unroll
            for (int q = 0; q < 16; ++q) { h = ar[q] * h + br_[q]; ap *= ar[q]; }
            segp[part * 64 + ch] = ap; segh[part * 64 + ch] = h;
            __syncthreads();
            float hin = (PASS == 1) ? LB[((size_t)c * 2 + d) * 512 + chg] : 0.f;
            float atot = 1.f;
#pragma unroll
            for (int pp = 0; pp < 4; ++pp) {
                const bool take = (PASS == 0) ? true : (pp < part);
                if (take) { hin = segp[pp * 64 + ch] * hin + segh[pp * 64 + ch]; atot *= segp[pp * 64 + ch]; }
            }
            if (PASS == 0) {
                if (part == 0) { LA[((size_t)c * 2 + d) * 512 + chg] = atot; LB[((size_t)c * 2 + d) * 512 + chg] = hin; }
            } else {
                float hh = hin;
#pragma unroll
                for (int q = 0; q < 16; ++q) {
                    const int pos = part * 16 + q, tk = d ? 63 - pos : pos;
                    hh = ar[q] * hh + br_[q];
                    if (d == 0) hsum[tk * 64 + ch] = hh; else hsum[tk * 64 + ch] += hh;
                }
            }
        }
        __syncthreads();
    }
    if (PASS == 1) {
        bf16* YS = (bf16*)(P.ws + WS_RB);
        for (int idx = tid; idx < 64 * 16; idx += 256) {
            const int tk = idx >> 4, c4 = idx & 15;
            float gf[4]; unpack4(*(const u32x2*)(Pm + (size_t)(t0 + tk) * WIN + OFF_LG + blk * 64 + c4 * 4), gf);
            const f32x4 h = *(const f32x4*)(hsum + tk * 64 + c4 * 4);
            *(u32x2*)(YS + (size_t)(t0 + tk) * 2048 + 1024 + blk * 64 + c4 * 4) = pack4(h[0] * gelu_t(gf[0]), h[1] * gelu_t(gf[1]), h[2] * gelu_t(gf[2]), h[3] * gelu_t(gf[3]));
        }
    }
    __syncthreads();
}
DI void lru_carry(const Params& P, int unit) {
    const int id = unit * 256 + otid(), d = id >> 9, chn = id & 511;
    float* LA = (float*)(P.ws + WS_LA); float* LB = (float*)(P.ws + WS_LB);
    float h = 0.f;
    for (int o0 = 0; o0 < NT; o0 += 13) {
        float a[13], b[13];
#pragma unroll
        for (int i = 0; i < 13; ++i) { const int c = tile_at(d, o0 + i); a[i] = LA[((size_t)c * 2 + d) * 512 + chn]; b[i] = LB[((size_t)c * 2 + d) * 512 + chn]; }
#pragma unroll
        for (int i = 0; i < 13; ++i) { const int c = tile_at(d, o0 + i); LB[((size_t)c * 2 + d) * 512 + chn] = h; h = a[i] * h + b[i]; }
    }
}

DI void gla_prep(const Params& P, int l, int c, int d, int head, unsigned char* smem, float* bs) {
    bf16* w1t = (bf16*)smem;
    bf16* w2t = (bf16*)(smem + 8448);
    bf16* t1 = (bf16*)(smem + 13568);
    const int tid = otid(), lane = tid & 63, wave = tid >> 6, l15 = lane & 15, quad = lane >> 4;
    const bf16* Pm = (const bf16*)(P.ws + WS_RA);
    const float* w1 = P.in[16] + ((size_t)l * 2 + d) * 256 * 16;
    const float* w2 = P.in[17] + ((size_t)l * 2 + d) * 16 * 256;
    for (int idx = tid; idx < 4096; idx += 256) { const int k = idx >> 4, r = idx & 15; w1t[r * 264 + k] = f2bf(w1[idx]); }
    for (int idx = tid; idx < 64 * 32; idx += 256) { const int n = idx >> 5, r = idx & 31; w2t[n * 40 + r] = r < 16 ? f2bf(w2[r * 256 + head * 64 + n]) : (bf16)0; }
    __syncthreads();
    {
        const bf16* xrow = Pm + (size_t)(c * 64 + wave * 16 + l15) * WIN + OFF_GK + quad * 8;
        const f32x4 a = mma_rows<8>(xrow, w1t + l15 * 264 + quad * 8, (f32x4){0.f, 0.f, 0.f, 0.f});
        const int tok = wave * 16 + l15;
        *(u32x2*)(t1 + tok * 40 + quad * 4) = pack4(a[0], a[1], a[2], a[3]);
        *(u32x2*)(t1 + tok * 40 + 16 + quad * 4) = (u32x2){0u, 0u};
    }
    __syncthreads();
    {
        const int tok = wave * 16 + l15;
#pragma unroll
        for (int nt = 0; nt < 4; ++nt) {
            const f32x4 a = mma_rows<1>(t1 + tok * 40 + quad * 8, w2t + (nt * 16 + l15) * 40 + quad * 8, (f32x4){0.f, 0.f, 0.f, 0.f});
            const int n0 = nt * 16 + quad * 4;
            const f32x4 bias = *(const f32x4*)(P.in[18] + ((size_t)l * 2 + d) * 256 + head * 64 + n0);
            f32x4 la;
#pragma unroll
            for (int r = 0; r < 4; ++r) { const float z = a[r] + bias[r]; la[r] = -softplus_(-z) * (1.f / 16.f); }
            *(f32x4*)(bs + tok * 64 + n0) = la;
        }
    }
    __syncthreads();
    {
        float* seg = (float*)smem;
        float v[16]; float run = 0.f;
#pragma unroll
        for (int q = 0; q < 16; ++q) { const int t = d ? wave * 16 + 15 - q : wave * 16 + q; run += bs[t * 64 + lane]; v[q] = run; }
        seg[wave * 64 + lane] = run;
        __syncthreads();
        float off = 0.f;
#pragma unroll
        for (int pp = 0; pp < 4; ++pp) { const bool take = d ? (pp > wave) : (pp < wave); off += take ? seg[pp * 64 + lane] : 0.f; }
#pragma unroll
        for (int q = 0; q < 16; ++q) { const int t = d ? wave * 16 + 15 - q : wave * 16 + q; bs[t * 64 + lane] = v[q] + off; }
    }
    __syncthreads();
}
DI void gla_load_vt(const Params& P, int c, int head, bf16* vt) {
    const bf16* Pm = (const bf16*)(P.ws + WS_RA);
    for (int idx = otid(); idx < 64 * 32; idx += 256) {
        const int tok = idx >> 5, v4 = idx & 31;
        const u32x2 v = *(const u32x2*)(Pm + (size_t)(c * 64 + tok) * WIN + OFF_GV + head * 128 + v4 * 4);
        vt[(v4 * 4 + 0) * 72 + tok] = (bf16)(v.x & 0xffffu); vt[(v4 * 4 + 1) * 72 + tok] = (bf16)(v.x >> 16);
        vt[(v4 * 4 + 2) * 72 + tok] = (bf16)(v.y & 0xffffu); vt[(v4 * 4 + 3) * 72 + tok] = (bf16)(v.y >> 16);
    }
}
DI void gla_passA(const Params& P, int l, int item, unsigned char* smem) {
    float* bs = (float*)(smem + 18688);
    bf16* vt = (bf16*)(smem + 35072);
    bf16* kt = (bf16*)(smem + 53504);
    const int tid = otid(), lane = tid & 63, wave = tid >> 6, l15 = lane & 15, quad = lane >> 4;
    const int head = item & 3, d = (item >> 2) & 1, c = item >> 3;
    const bf16* Pm = (const bf16*)(P.ws + WS_RA);
    __syncthreads();
    gla_prep(P, l, c, d, head, smem, bs);
    {
        float* gbs = (float*)(P.ws + WS_GBS) + (size_t)item * 4096;
        for (int idx = tid; idx < 1024; idx += 256) *(f32x4*)(gbs + idx * 4) = *(const f32x4*)(bs + idx * 4);
    }
    gla_load_vt(P, c, head, vt);
    const int tl = d ? 0 : 63;
    for (int idx = tid; idx < 64 * 16; idx += 256) {
        const int tok = idx >> 4, k4 = idx & 15;
        float kf[4]; unpack4(*(const u32x2*)(Pm + (size_t)(c * 64 + tok) * WIN + OFF_GK + head * 64 + k4 * 4), kf);
#pragma unroll
        for (int r = 0; r < 4; ++r) { const int kk = k4 * 4 + r; kt[kk * 72 + tok] = f2bf(kf[r] * __expf(bs[tl * 64 + kk] - bs[tok * 64 + kk])); }
    }
    if (tid < 64) ((float*)(P.ws + WS_GDEC))[(size_t)item * 64 + tid] = __expf(bs[tl * 64 + tid]);
    __syncthreads();
    bf16* DS = (bf16*)(P.ws + WS_RC) + (size_t)item * 128 * 64;
#pragma unroll
    for (int mt2 = 0; mt2 < 2; ++mt2) {
        const int mt = wave * 2 + mt2;
#pragma unroll
        for (int nt = 0; nt < 4; ++nt) {
            const f32x4 a = mma_rows<2>(vt + (mt * 16 + l15) * 72 + quad * 8, kt + (nt * 16 + l15) * 72 + quad * 8, (f32x4){0.f, 0.f, 0.f, 0.f});
            *(u32x2*)(DS + (size_t)(mt * 16 + l15) * 64 + nt * 16 + quad * 4) = pack4(a[0], a[1], a[2], a[3]);
        }
    }
    __syncthreads();
}
DI void gla_carry(const Params& P, int unit) {
    const int id = unit * 256 + otid(), d = id >> 13, head = (id >> 11) & 3, vv = (id >> 4) & 127, kq = id & 15;
    bf16* S = (bf16*)(P.ws + WS_RC); const float* DEC = (const float*)(P.ws + WS_GDEC);
    float s[4] = {0.f, 0.f, 0.f, 0.f};
    for (int o0 = 0; o0 < NT; o0 += 10) {
        u32x2 dsv[10]; f32x4 dc[10];
#pragma unroll
        for (int i = 0; i < 10; ++i) {
            const size_t it = ((size_t)tile_at(d, o0 + i) * 2 + d) * 4 + head;
            dsv[i] = *(const u32x2*)(S + (it * 128 + vv) * 64 + kq * 4); dc[i] = *(const f32x4*)(DEC + it * 64 + kq * 4);
        }
#pragma unroll
        for (int i = 0; i < 10; ++i) {
            const size_t it = ((size_t)tile_at(d, o0 + i) * 2 + d) * 4 + head;
            *(u32x2*)(S + (it * 128 + vv) * 64 + kq * 4) = pack4(s[0], s[1], s[2], s[3]);
            float f[4]; unpack4(dsv[i], f);
#pragma unroll
            for (int r = 0; r < 4; ++r) s[r] = dc[i][r] * s[r] + f[r];
        }
    }
}
DI void gla_passC(const Params& P, int l, int item, unsigned char* smem) {
    bf16* att = (bf16*)smem;
    float* bs = (float*)(smem + 18688);
    bf16* qe = (bf16*)(smem + 35072);
    bf16* ke = (bf16*)(smem + 44288);
    bf16* vs = (bf16*)(smem + 53504);
    const int tid = otid(), lane = tid & 63, wave = tid >> 6, l15 = lane & 15, quad = lane >> 4;
    const int head = item & 3, c = item >> 2;
    const bf16* Pm = (const bf16*)(P.ws + WS_RA);
    f32x4 o[8];
#pragma unroll
    for (int i = 0; i < 8; ++i) o[i] = (f32x4){0.f, 0.f, 0.f, 0.f};
    __syncthreads();
    for (int d = 0; d < 2; ++d) {
        {
            const float* gbs = (const float*)(P.ws + WS_GBS) + (size_t)((c * 2 + d) * 4 + head) * 4096;
            for (int idx = tid; idx < 1024; idx += 256) *(f32x4*)(bs + idx * 4) = *(const f32x4*)(gbs + idx * 4);
            __syncthreads();
        }
        const int tm = d ? 31 : 32;
        for (int idx = tid; idx < 64 * 16; idx += 256) {
            const int tok = idx >> 4, k4 = idx & 15;
            float qf[4], kf[4];
            unpack4(*(const u32x2*)(Pm + (size_t)(c * 64 + tok) * WIN + OFF_GQ + head * 64 + k4 * 4), qf);
            unpack4(*(const u32x2*)(Pm + (size_t)(c * 64 + tok) * WIN + OFF_GK + head * 64 + k4 * 4), kf);
            float qo[4], ko[4];
#pragma unroll
            for (int r = 0; r < 4; ++r) { const int kk = k4 * 4 + r; const float db = bs[tok * 64 + kk] - bs[tm * 64 + kk]; qo[r] = qf[r] * 0.125f * __expf(db); ko[r] = kf[r] * __expf(-db); }
            *(u32x2*)(qe + tok * 72 + k4 * 4) = pack4(qo[0], qo[1], qo[2], qo[3]);
            *(u32x2*)(ke + tok * 72 + k4 * 4) = pack4(ko[0], ko[1], ko[2], ko[3]);
        }
        gla_load_vt(P, c, head, vs);
        __syncthreads();
        {
            const int i = wave * 16 + l15;
#pragma unroll
            for (int nt = 0; nt < 4; ++nt) {
                f32x4 a = mma_rows<2>(qe + i * 72 + quad * 8, ke + (nt * 16 + l15) * 72 + quad * 8, (f32x4){0.f, 0.f, 0.f, 0.f});
#pragma unroll
                for (int r = 0; r < 4; ++r) { const int j = nt * 16 + quad * 4 + r; const bool keep = d ? (j >= i) : (j <= i); a[r] = keep ? a[r] : 0.f; }
                *(u32x2*)(att + i * 72 + nt * 16 + quad * 4) = pack4(a[0], a[1], a[2], a[3]);
            }
        }
        __syncthreads();
#pragma unroll
        for (int nt = 0; nt < 8; ++nt) o[nt] = mma_rows<2>(att + (wave * 16 + l15) * 72 + quad * 8, vs + (nt * 16 + l15) * 72 + quad * 8, o[nt]);
        __syncthreads();
        {
            const bf16* S = (const bf16*)(P.ws + WS_RC) + (((size_t)c * 2 + d) * 4 + head) * 128 * 64;
            for (int idx = tid; idx < 128 * 16; idx += 256) {
                const int vv = idx >> 4, k4 = idx & 15;
                float f[4]; unpack4(*(const u32x2*)(S + (size_t)vv * 64 + k4 * 4), f);
#pragma unroll
                for (int r = 0; r < 4; ++r) f[r] *= __expf(bs[tm * 64 + k4 * 4 + r]);
                *(u32x2*)(vs + vv * 72 + k4 * 4) = pack4(f[0], f[1], f[2], f[3]);
            }
        }
        __syncthreads();
#pragma unroll
        for (int nt = 0; nt < 8; ++nt) o[nt] = mma_rows<2>(qe + (wave * 16 + l15) * 72 + quad * 8, vs + (nt * 16 + l15) * 72 + quad * 8, o[nt]);
        __syncthreads();
    }
    float ss = 0.f;
#pragma unroll
    for (int nt = 0; nt < 8; ++nt)
#pragma unroll
        for (int r = 0; r < 4; ++r) ss += o[nt][r] * o[nt][r];
    ss += __shfl_xor(ss, 16); ss += __shfl_xor(ss, 32);
    const float rstd = rsqrtf(ss * (1.f / 128.f) + 1e-6f);
    const int t = c * 64 + wave * 16 + l15;
    bf16* YS = (bf16*)(P.ws + WS_RB);
#pragma unroll
    for (int nt = 0; nt < 8; ++nt) {
        const int vv = nt * 16 + quad * 4;
        const f32x4 nw = *(const f32x4*)(P.in[19] + (size_t)l * 128 + vv);
        float gf[4]; unpack4(*(const u32x2*)(Pm + (size_t)t * WIN + OFF_GG + head * 128 + vv), gf);
        *(u32x2*)(YS + (size_t)t * 2048 + 512 + head * 128 + vv) =
            pack4(o[nt][0] * rstd * nw[0] * silu_(gf[0]), o[nt][1] * rstd * nw[1] * silu_(gf[1]), o[nt][2] * rstd * nw[2] * silu_(gf[2]), o[nt][3] * rstd * nw[3] * silu_(gf[3]));
    }
    __syncthreads();
}

DI void rw_mix4(const bf16* Pm, int t, int col, const float* mu, float* o) {
    const int seglo = t < CTX ? 0 : (t & ~63), seghi = t < CTX ? CTX : seglo + 64;
    float x[4], xm[4] = {0.f, 0.f, 0.f, 0.f}, xp[4] = {0.f, 0.f, 0.f, 0.f};
    unpack4(*(const u32x2*)(Pm + (size_t)t * WIN + col), x);
    if (t > seglo) unpack4(*(const u32x2*)(Pm + (size_t)(t - 1) * WIN + col), xm);
    if (t + 1 < seghi) unpack4(*(const u32x2*)(Pm + (size_t)(t + 1) * WIN + col), xp);
#pragma unroll
    for (int r = 0; r < 4; ++r) o[r] = x[r] + mu[r] * (0.5f * (xm[r] + xp[r]) - x[r]);
}
DI void rw_build_chunk(const Params& P, int l, int c, int which, int kc, bf16* kx) {
    const bf16* Pm = (const bf16*)(P.ws + WS_RA);
    const int off = which == 0 ? OFF_RR : (which == 1 ? OFF_RK : OFF_RV);
    for (int idx = otid(); idx < 64 * 32; idx += 256) {
        const int tok = idx >> 5, c4 = idx & 31, col = kc * 128 + c4 * 4;
        const f32x4 mu = *(const f32x4*)(P.in[27] + ((size_t)l * 3 + which) * 512 + col);
        float muf[4] = {mu[0], mu[1], mu[2], mu[3]}, o[4];
        rw_mix4(Pm, c * 64 + tok, off + col, muf, o);
        *(u32x2*)(kx + tok * 136 + c4 * 4) = pack4(o[0], o[1], o[2], o[3]);
    }
}
DI void rw_prep(const Params& P, int l, int item, unsigned char* smem) {
    bf16* kx = (bf16*)smem;
    bf16* w1c = (bf16*)(smem + 17408);
    bf16* a1c = (bf16*)(smem + 34816);
    bf16* hws = (bf16*)smem;
    bf16* has = (bf16*)(smem + 9216);
    bf16* w2c = (bf16*)(smem + 18432);
    bf16* a2c = (bf16*)(smem + 36864);
    const int tid = otid(), lane = tid & 63, wave = tid >> 6, l15 = lane & 15, quad = lane >> 4;
    const int c = item >> 1, d = item & 1;
    const bf16* WB = (const bf16*)(P.ws + WS_WB);
    f32x4 aw[4], aa[4];
#pragma unroll
    for (int i = 0; i < 4; ++i) { aw[i] = (f32x4){0.f, 0.f, 0.f, 0.f}; aa[i] = (f32x4){0.f, 0.f, 0.f, 0.f}; }
    for (int kc = 0; kc < 4; ++kc) {
        __syncthreads();
        rw_build_chunk(P, l, c, 1, kc, kx);
        for (int idx = tid; idx < 64 * 16; idx += 256) {
            const int n = idx >> 4, k8 = idx & 15;
            *(u32x4*)(w1c + n * 136 + k8 * 8) = *(const u32x4*)(WB + WB_RW1 + ((size_t)d * 64 + n) * 512 + kc * 128 + k8 * 8);
            *(u32x4*)(a1c + n * 136 + k8 * 8) = *(const u32x4*)(WB + WB_RA1 + ((size_t)d * 64 + n) * 512 + kc * 128 + k8 * 8);
        }
        __syncthreads();
#pragma unroll
        for (int nt = 0; nt < 4; ++nt) {
            aw[nt] = mma_rows<4>(kx + (wave * 16 + l15) * 136 + quad * 8, w1c + (nt * 16 + l15) * 136 + quad * 8, aw[nt]);
            aa[nt] = mma_rows<4>(kx + (wave * 16 + l15) * 136 + quad * 8, a1c + (nt * 16 + l15) * 136 + quad * 8, aa[nt]);
        }
    }
    __syncthreads();
    {
        const int tok = wave * 16 + l15;
#pragma unroll
        for (int nt = 0; nt < 4; ++nt) {
            *(u32x2*)(hws + tok * 72 + nt * 16 + quad * 4) = pack4(tanh_(aw[nt][0]), tanh_(aw[nt][1]), tanh_(aw[nt][2]), tanh_(aw[nt][3]));
            *(u32x2*)(has + tok * 72 + nt * 16 + quad * 4) = pack4(aa[nt][0], aa[nt][1], aa[nt][2], aa[nt][3]);
        }
    }
    f16* WA = (f16*)(P.ws + WS_RW) + (size_t)d * T * 512;
    f16* AG = (f16*)(P.ws + WS_RW) + (size_t)(2 + d) * T * 512;
    for (int nc = 0; nc < 4; ++nc) {
        __syncthreads();
        for (int idx = tid; idx < 128 * 8; idx += 256) {
            const int n = idx >> 3, k8 = idx & 7;
            *(u32x4*)(w2c + n * 72 + k8 * 8) = *(const u32x4*)(WB + WB_RW2 + ((size_t)d * 512 + nc * 128 + n) * 64 + k8 * 8);
            *(u32x4*)(a2c + n * 72 + k8 * 8) = *(const u32x4*)(WB + WB_RA2 + ((size_t)d * 512 + nc * 128 + n) * 64 + k8 * 8);
        }
        __syncthreads();
        const int tok = wave * 16 + l15, t = c * 64 + tok;
#pragma unroll
        for (int nt = 0; nt < 8; ++nt) {
            const f32x4 zw = mma_rows<2>(hws + tok * 72 + quad * 8, w2c + (nt * 16 + l15) * 72 + quad * 8, (f32x4){0.f, 0.f, 0.f, 0.f});
            const f32x4 za = mma_rows<2>(has + tok * 72 + quad * 8, a2c + (nt * 16 + l15) * 72 + quad * 8, (f32x4){0.f, 0.f, 0.f, 0.f});
            const int n = nc * 128 + nt * 16 + quad * 4;
            const f32x4 w0 = *(const f32x4*)(P.in[28] + ((size_t)l * 2 + d) * 512 + n), a0 = *(const f32x4*)(P.in[31] + ((size_t)l * 2 + d) * 512 + n);
            f16x4 wo, ao;
#pragma unroll
            for (int r = 0; r < 4; ++r) { wo[r] = (f16)__expf(-0.6065306597126334f * sigm(w0[r] + zw[r])); ao[r] = (f16)sigm(a0[r] + za[r]); }
            *(f16x4*)(WA + (size_t)t * 512 + n) = wo; *(f16x4*)(AG + (size_t)t * 512 + n) = ao;
        }
    }
    __syncthreads();
}
constexpr int NSEG = 8, SEGQ = NT * 4 / NSEG;
struct RwRaw { u32x2 r[3], k[3], v[3]; f16x4 w, a; };
struct RwStep { f32x4 w0, w1, a0, a1, b0, b1, k0, k1, r0, r1; float v; };
DI float dot8(f32x4 x0, f32x4 x1, f32x4 y0, f32x4 y1) {
    f32x2 acc = __builtin_shufflevector(x0, x0, 0, 1) * __builtin_shufflevector(y0, y0, 0, 1);
    acc = __builtin_shufflevector(x0, x0, 2, 3) * __builtin_shufflevector(y0, y0, 2, 3) + acc;
    acc = __builtin_shufflevector(x1, x1, 0, 1) * __builtin_shufflevector(y1, y1, 0, 1) + acc;
    acc = __builtin_shufflevector(x1, x1, 2, 3) * __builtin_shufflevector(y1, y1, 2, 3) + acc;
    return acc[0] + acc[1];
}
DI float row8_sum(float x) { x = dpp_add<0xB1>(x); x = dpp_add<0x4E>(x); x = dpp_add<0x141>(x); return x; }
template <int MODE> DI void rw_scan(const Params& P, int l, int unit, unsigned char* smem) {
    float* ops = (float*)smem;
    float* ybuf = (float*)(smem + 49152);
    const int tid = otid(), lane = tid & 63, wave = tid >> 6;
    const int half = unit & 1, seg = (unit >> 1) % NSEG, hd = (unit >> 1) / NSEG, d = hd >> 3, head = hd & 7;
    const bf16* Pm = (const bf16*)(P.ws + WS_RA);
    const f16* WA = (const f16*)(P.ws + WS_RW) + (size_t)d * T * 512;
    const f16* AG = (const f16*)(P.ws + WS_RW) + (size_t)(2 + d) * T * 512;
    bf16* Yout = d == 0 ? (bf16*)(P.ws + WS_RB) + 1536 : (bf16*)(P.ws + WS_RY);
    const int ystride = d == 0 ? 2048 : 512;
    float* RSEG = (float*)(P.ws + WS_RSEG);
    const int stok = tid >> 4, cg = tid & 15, col = head * 64 + cg * 4;
    const f32x4 mu_r = *(const f32x4*)(P.in[27] + ((size_t)l * 3 + 0) * 512 + col), mu_k = *(const f32x4*)(P.in[27] + ((size_t)l * 3 + 1) * 512 + col), mu_v = *(const f32x4*)(P.in[27] + ((size_t)l * 3 + 2) * 512 + col);
    const f32x4 kkw = *(const f32x4*)(P.in[36] + (size_t)l * 512 + col), kaw = *(const f32x4*)(P.in[37] + (size_t)l * 512 + col);
    const int r8 = lane >> 3, c8 = lane & 7, rowl = wave * 8 + r8, row = half * 32 + rowl;
    f32x4 s0, s1;
    if (MODE == 0) { s0 = (f32x4){0.f, 0.f, 0.f, 0.f}; s1 = s0; }
    else if (MODE == 1) {
#pragma unroll
        for (int i = 0; i < 4; ++i) { s0[i] = (c8 * 8 + i == row) ? 1.f : 0.f; s1[i] = (c8 * 8 + 4 + i == row) ? 1.f : 0.f; }
    } else {
        float* Sl = (float*)smem;
        float* Pl = Sl + 2048;
        s0 = (f32x4){0.f, 0.f, 0.f, 0.f}; s1 = s0;
        for (int sg = 0; sg < seg; ++sg) {
            const float* Ls = RSEG + (((size_t)0 * 16 + hd) * NSEG + sg) * 4096;
            const float* Ps = RSEG + (((size_t)1 * 16 + hd) * NSEG + sg) * 4096;
            __syncthreads();
            *(f32x4*)(Sl + rowl * 64 + c8 * 8) = s0; *(f32x4*)(Sl + rowl * 64 + c8 * 8 + 4) = s1;
            for (int idx = tid; idx < 1024; idx += 256) *(f32x4*)(Pl + idx * 4) = *(const f32x4*)(Ps + idx * 4);
            __syncthreads();
            f32x4 a0 = *(const f32x4*)(Ls + row * 64 + c8 * 8), a1 = *(const f32x4*)(Ls + row * 64 + c8 * 8 + 4);
#pragma unroll 8
            for (int m = 0; m < 64; ++m) {
                const float sv = Sl[rowl * 64 + m];
                a0 += *(const f32x4*)(Pl + m * 64 + c8 * 8) * sv; a1 += *(const f32x4*)(Pl + m * 64 + c8 * 8 + 4) * sv;
            }
            s0 = a0; s1 = a1;
        }
    }
    RwRaw raw;
    auto tok_of = [&](int q, int j) -> int { const int o = q >> 2, sub = q & 3, c = tile_at(d, o), pos = sub * 16 + j; return c * 64 + (d ? 63 - pos : pos); };
    auto prefetch = [&](int q) {
        const int t = tok_of(q, stok);
        const int seglo = t < CTX ? 0 : (t & ~63), seghi = t < CTX ? CTX : seglo + 64;
        const int tm = t > seglo ? t - 1 : t, tp = t + 1 < seghi ? t + 1 : t;
        const bf16* b0 = Pm + (size_t)t * WIN + col; const bf16* bm = Pm + (size_t)tm * WIN + col; const bf16* bp = Pm + (size_t)tp * WIN + col;
        raw.r[0] = *(const u32x2*)(bm + OFF_RR); raw.r[1] = *(const u32x2*)(b0 + OFF_RR); raw.r[2] = *(const u32x2*)(bp + OFF_RR);
        raw.k[0] = *(const u32x2*)(bm + OFF_RK); raw.k[1] = *(const u32x2*)(b0 + OFF_RK); raw.k[2] = *(const u32x2*)(bp + OFF_RK);
        raw.v[0] = *(const u32x2*)(bm + OFF_RV); raw.v[1] = *(const u32x2*)(b0 + OFF_RV); raw.v[2] = *(const u32x2*)(bp + OFF_RV);
        raw.w = *(const f16x4*)(WA + (size_t)t * 512 + col); raw.a = *(const f16x4*)(AG + (size_t)t * 512 + col);
    };
    auto stage = [&](int q, int buf) {
        const int t = tok_of(q, stok);
        const int seglo = t < CTX ? 0 : (t & ~63), seghi = t < CTX ? CTX : seglo + 64;
        const float mm = t > seglo ? 0.5f : 0.f, mp = t + 1 < seghi ? 0.5f : 0.f;
        float rm[4], r0[4], rp[4], km[4], k0[4], kp[4], vm[4], v0[4], vp[4];
        unpack4(raw.r[0], rm); unpack4(raw.r[1], r0); unpack4(raw.r[2], rp);
        unpack4(raw.k[0], km); unpack4(raw.k[1], k0); unpack4(raw.k[2], kp);
        unpack4(raw.v[0], vm); unpack4(raw.v[1], v0); unpack4(raw.v[2], vp);
        f32x4 rr, kk, vv, kd, aa, bb, ww; float ssq = 0.f;
#pragma unroll
        for (int i = 0; i < 4; ++i) {
            rr[i] = r0[i] + mu_r[i] * (mm * rm[i] + mp * rp[i] - r0[i]);
            const float kx = k0[i] + mu_k[i] * (mm * km[i] + mp * kp[i] - k0[i]);
            vv[i] = v0[i] + mu_v[i] * (mm * vm[i] + mp * vp[i] - v0[i]);
            const float kr = kx * kkw[i]; kk[i] = kr; ssq += kr * kr;
            const float ag = (float)raw.a[i];
            kd[i] = kx * (1.f + (ag - 1.f) * kaw[i]); bb[i] = ag; ww[i] = (float)raw.w[i];
        }
        ssq = row16_sum(ssq);
        const float inv = __builtin_amdgcn_rsqf(fmaxf(ssq, 1e-24f));
#pragma unroll
        for (int i = 0; i < 4; ++i) { const float kn = kk[i] * inv; aa[i] = -kn; bb[i] = kn * bb[i]; }
        float* op = ops + ((size_t)buf * 16 + stok) * 384 + cg * 4;
        *(f32x4*)(op + 0) = ww; *(f32x4*)(op + 64) = aa; *(f32x4*)(op + 128) = bb;
        if (MODE != 1) { *(f32x4*)(op + 192) = kd; *(f32x4*)(op + 320) = vv; }
        if (MODE == 2) *(f32x4*)(op + 256) = rr;
    };
    auto ldstep = [&](const float* op) -> RwStep {
        RwStep x;
        x.w0 = *(const f32x4*)(op + c8 * 8); x.w1 = *(const f32x4*)(op + c8 * 8 + 4);
        x.a0 = *(const f32x4*)(op + 64 + c8 * 8); x.a1 = *(const f32x4*)(op + 64 + c8 * 8 + 4);
        x.b0 = *(const f32x4*)(op + 128 + c8 * 8); x.b1 = *(const f32x4*)(op + 128 + c8 * 8 + 4);
        if (MODE != 1) { x.k0 = *(const f32x4*)(op + 192 + c8 * 8); x.k1 = *(const f32x4*)(op + 192 + c8 * 8 + 4); x.v = op[320 + row]; }
        if (MODE == 2) { x.r0 = *(const f32x4*)(op + 256 + c8 * 8); x.r1 = *(const f32x4*)(op + 256 + c8 * 8 + 4); }
        return x;
    };
    const int q0 = seg * SEGQ;
    __syncthreads();
    prefetch(q0); stage(q0, 0);
    __syncthreads();
    for (int qi = 0; qi < SEGQ; ++qi) {
        const int q = q0 + qi, buf = qi & 1;
        if (qi + 1 < SEGQ) prefetch(q + 1);
        const float* ob = ops + (size_t)buf * 16 * 384;
        RwStep cur = ldstep(ob);
        float yv[16];
#pragma unroll
        for (int j = 0; j < 16; ++j) {
            RwStep nxt;
            if (j < 15) nxt = ldstep(ob + (j + 1) * 384);
            float sa = dot8(s0, s1, cur.a0, cur.a1);
            sa = row8_sum(sa);
            if (MODE != 1) { s0 = s0 * cur.w0 + (cur.b0 * sa + cur.k0 * cur.v); s1 = s1 * cur.w1 + (cur.b1 * sa + cur.k1 * cur.v); }
            else { s0 = s0 * cur.w0 + cur.b0 * sa; s1 = s1 * cur.w1 + cur.b1 * sa; }
            if (MODE == 2) {
                float y = dot8(s0, s1, cur.r0, cur.r1);
                yv[j] = row8_sum(y);
            }
            if (j < 15) cur = nxt;
        }
        if (MODE == 2 && c8 == 0) {
#pragma unroll
            for (int j = 0; j < 16; ++j) ybuf[(buf * 16 + j) * 32 + rowl] = yv[j];
        }
        if (qi + 1 < SEGQ) stage(q + 1, buf ^ 1);
        __syncthreads();
        if (MODE == 2) {
#pragma unroll
            for (int e = 0; e < 2; ++e) {
                const int idx = tid + 256 * e, j = idx >> 5, rw = idx & 31;
                Yout[(size_t)tok_of(q, j) * ystride + head * 64 + half * 32 + rw] = f2bf(ybuf[(buf * 16 + j) * 32 + rw]);
            }
        }
    }
    if (MODE != 2) {
        float* sp = RSEG + ((((size_t)MODE * 16 + hd) * NSEG + seg) * 64 + row) * 64 + c8 * 8;
        *(f32x4*)sp = s0; *(f32x4*)(sp + 4) = s1;
    }
    __syncthreads();
}
DI void rw_combine(const Params& P, int hd, unsigned char* smem) {
    float* S = (float*)smem;
    float* Pm = S + 4096;
    float* RSEG = (float*)(P.ws + WS_RSEG);
    const int tid = otid(), i = tid >> 2, nq = tid & 3;
    __syncthreads();
    for (int idx = tid; idx < 4096; idx += 256) S[idx] = 0.f;
    __syncthreads();
    for (int seg = 0; seg < NSEG; ++seg) {
        const float* Ls = RSEG + (((size_t)0 * 16 + hd) * NSEG + seg) * 4096;
        const float* Ps = RSEG + (((size_t)1 * 16 + hd) * NSEG + seg) * 4096;
        float* St = RSEG + (((size_t)2 * 16 + hd) * NSEG + seg) * 4096;
        for (int idx = tid; idx < 4096; idx += 256) { St[idx] = S[idx]; Pm[idx] = Ps[idx]; }
        __syncthreads();
        float acc[16];
#pragma unroll
        for (int n = 0; n < 16; ++n) acc[n] = Ls[i * 64 + nq * 16 + n];
        for (int m = 0; m < 64; ++m) {
            const float sv = S[i * 64 + m];
#pragma unroll
            for (int n = 0; n < 16; ++n) acc[n] += sv * Pm[m * 64 + nq * 16 + n];
        }
        __syncthreads();
#pragma unroll
        for (int n = 0; n < 16; ++n) S[i * 64 + nq * 16 + n] = acc[n];
        __syncthreads();
    }
}
DI void rw_passC(const Params& P, int l, int item, unsigned char* smem) {
    const int c = item >> 1, hf = item & 1;
    float* stat = (float*)smem;
    bf16* kx = (bf16*)(smem + 8192);
    bf16* gc = (bf16*)(smem + 25600);
    const int tid = otid(), lane = tid & 63, wave = tid >> 6, l15 = lane & 15, quad = lane >> 4;
    const bf16* Pm = (const bf16*)(P.ws + WS_RA);
    const bf16* WB = (const bf16*)(P.ws + WS_WB);
    bf16* YS = (bf16*)(P.ws + WS_RB); const bf16* RY = (const bf16*)(P.ws + WS_RY);
    __syncthreads();
    {
        const int c4 = tid & 15;
        for (int it = 0; it < 16; ++it) {
            const int pair = it * 16 + (tid >> 4), tok = pair >> 2, hh = pair & 3, head = hf * 4 + hh, t = c * 64 + tok, col = head * 64 + c4 * 4;
            float yf[4], yb[4], rr[4], kk[4];
            unpack4(*(const u32x2*)(YS + (size_t)t * 2048 + 1536 + col), yf); unpack4(*(const u32x2*)(RY + (size_t)t * 512 + col), yb);
            const f32x4 mu0 = *(const f32x4*)(P.in[27] + ((size_t)l * 3 + 0) * 512 + col), mu1 = *(const f32x4*)(P.in[27] + ((size_t)l * 3 + 1) * 512 + col);
            const f32x4 rk = *(const f32x4*)(P.in[38] + (size_t)l * 512 + col);
            float m0[4] = {mu0[0], mu0[1], mu0[2], mu0[3]}, m1[4] = {mu1[0], mu1[1], mu1[2], mu1[3]};
            rw_mix4(Pm, t, OFF_RR + col, m0, rr); rw_mix4(Pm, t, OFF_RK + col, m1, kk);
            float sy = 0.f, sy2 = 0.f, sb = 0.f;
#pragma unroll
            for (int r = 0; r < 4; ++r) { const float y = yf[r] + yb[r]; sy += y; sy2 += y * y; sb += rr[r] * kk[r] * rk[r]; }
            sy = row16_sum(sy); sy2 = row16_sum(sy2); sb = row16_sum(sb);
            const float mean = sy * (1.f / 64.f), var = fmaxf(sy2 * (1.f / 64.f) - mean * mean, 0.f);
            if (c4 == 0) *(f32x4*)(stat + (tok * 4 + hh) * 4) = (f32x4){mean, rsqrtf(var + 64e-5f), sb, 0.f};
        }
    }
    f32x4 ag[8];
#pragma unroll
    for (int i = 0; i < 8; ++i) ag[i] = (f32x4){0.f, 0.f, 0.f, 0.f};
    for (int kc = 0; kc < 4; ++kc) {
        __syncthreads();
        rw_build_chunk(P, l, c, 0, kc, kx);
        for (int idx = tid; idx < 128 * 16; idx += 256) {
            const int n = idx >> 4, k8 = idx & 15;
            *(u32x4*)(gc + n * 136 + k8 * 8) = *(const u32x4*)(WB + WB_RG1 + (size_t)n * 512 + kc * 128 + k8 * 8);
        }
        __syncthreads();
#pragma unroll
        for (int nt = 0; nt < 8; ++nt) ag[nt] = mma_rows<4>(kx + (wave * 16 + l15) * 136 + quad * 8, gc + (nt * 16 + l15) * 136 + quad * 8, ag[nt]);
    }
    __syncthreads();
    {
        const int tok = wave * 16 + l15;
#pragma unroll
        for (int nt = 0; nt < 8; ++nt) *(u32x2*)(kx + tok * 136 + nt * 16 + quad * 4) = pack4(sigm(ag[nt][0]), sigm(ag[nt][1]), sigm(ag[nt][2]), sigm(ag[nt][3]));
    }
    for (int nc = 2 * hf; nc < 2 * hf + 2; ++nc) {
        __syncthreads();
        for (int idx = tid; idx < 128 * 16; idx += 256) {
            const int n = idx >> 4, k8 = idx & 15;
            *(u32x4*)(gc + n * 136 + k8 * 8) = *(const u32x4*)(WB + WB_RG2 + ((size_t)nc * 128 + n) * 128 + k8 * 8);
        }
        __syncthreads();
        const int tok = wave * 16 + l15, t = c * 64 + tok;
#pragma unroll
        for (int nt = 0; nt < 8; ++nt) {
            const f32x4 g = mma_rows<4>(kx + tok * 136 + quad * 8, gc + (nt * 16 + l15) * 136 + quad * 8, (f32x4){0.f, 0.f, 0.f, 0.f});
            const int n = nc * 128 + nt * 16 + quad * 4, head = n >> 6;
            const f32x4 st = *(const f32x4*)(stat + (tok * 4 + (head & 3)) * 4);
            float yf[4], yb[4], vv[4];
            unpack4(*(const u32x2*)(YS + (size_t)t * 2048 + 1536 + n), yf); unpack4(*(const u32x2*)(RY + (size_t)t * 512 + n), yb);
            const f32x4 mu2 = *(const f32x4*)(P.in[27] + ((size_t)l * 3 + 2) * 512 + n);
            float m2[4] = {mu2[0], mu2[1], mu2[2], mu2[3]};
            rw_mix4(Pm, t, OFF_RV + n, m2, vv);
            const f32x4 lw = *(const f32x4*)(P.in[39] + (size_t)l * 512 + n), lb = *(const f32x4*)(P.in[40] + (size_t)l * 512 + n);
            float o[4];
#pragma unroll
            for (int r = 0; r < 4; ++r) o[r] = (((yf[r] + yb[r]) - st[0]) * st[1] * lw[r] + lb[r] + st[2] * vv[r]) * g[r];
            *(u32x2*)(YS + (size_t)t * 2048 + 1536 + n) = pack4(o[0], o[1], o[2], o[3]);
        }
    }
    __syncthreads();
}


#define NREP(k) ((DUPMASK >> (k)) & 1 ? 2 : 1)
#ifndef STOP_AT
#define STOP_AT 99
#endif
#ifndef DUMP_SEL
#define DUMP_SEL 0
#endif
DI void dbg_dump(const Params& P, const bf16* src, int stride, int col0, int ncols) {
    for (size_t i = (size_t)blockIdx.x * 256 + threadIdx.x; i < (size_t)SEQ * 1024; i += (size_t)gridDim.x * 256) {
        const int t = (int)(i >> 10), j = (int)(i & 1023);
        float v = 0.f;
        for (int c = j; c < ncols; c += 1024) v += bf2f(src[(size_t)t * stride + col0 + c]);
        P.out[i] = v;
    }
}

#if DUMP_SEL == 1
#define DBG_DUMP() dbg_dump(P, (const bf16*)(P.ws + WS_RB), 2048, 0, 2048)
#elif DUMP_SEL == 2
#define DBG_DUMP() dbg_dump(P, (const bf16*)(P.ws + WS_RA), 4608, 0, 4608)
#elif DUMP_SEL == 3
#define DBG_DUMP() dbg_dump(P, (const bf16*)(P.ws + WS_RB), 2048, 512, 512)
#elif DUMP_SEL == 4
#define DBG_DUMP() dbg_dump(P, (const bf16*)(P.ws + WS_RB), 2048, 1024, 512)
#elif DUMP_SEL == 5
#define DBG_DUMP() dbg_dump(P, (const bf16*)(P.ws + WS_RB), 2048, 1536, 512)
#elif DUMP_SEL == 6
#define DBG_DUMP() dbg_dump(P, (const bf16*)(P.ws + WS_YT), 512, 0, 512)
#elif DUMP_SEL == 7
#define DBG_DUMP() dbg_dump(P, (const bf16*)(P.ws + WS_RC), 1024, 0, 1024)
#else
#define DBG_DUMP() do {} while (0)
#endif
#define PHASE_END(id) do { GSYNC(); if ((id) == STOP_AT && l == 0) { DBG_DUMP(); return; } } while (0)

template <int N> struct IC { static constexpr int value = N; };
template <int NIL, class Body> DI int gemm_tiles(int bid, int G, int base, int N, bool ctx, Body body, bool latent = true) {
    const int ntL = N / (32 * NIL), ntC = N / 32, nL = latent ? 128 * ntL : 0, nAll = nL + (ctx ? 2 * ntC : 0);
    if (latent && G == 512 && base % 512 == 0 && (ntL % 8 == 0 || ntL % 8 == 4)) {
        const int x = bid & 7, j = bid >> 3, fc = ntL >> 3, nfull = 16 * fc, npatch = nfull + ((ntL & 7) ? 8 : 0);
        for (int p = x; p < npatch; p += 8) {
            int tm, tn;
            if (p < nfull) { tm = (p & 15) * 8 + (j >> 3); tn = (p >> 4) * 8 + (j & 7); }
            else { tm = (p - nfull) * 16 + (j >> 2); tn = fc * 8 + (j & 3); }
            body(IC<NIL>{}, 2 + tm, tn * 32 * NIL);
        }
        for (int t2 = bid; t2 < nAll - nL; t2 += G) body(IC<1>{}, t2 / ntC, (t2 % ntC) * 32);
        return base + ((nAll + 511) / 512) * 512;
    }
    int first = (bid - base) % G; if (first < 0) first += G;
    for (int tile = first; tile < nAll; tile += G) {
        if (tile < nL) body(IC<NIL>{}, 2 + tile / ntL, (tile % ntL) * 32 * NIL);
        else { const int t2 = tile - nL; body(IC<1>{}, t2 / ntC, (t2 % ntC) * 32); }
    }
    return base + nAll;
}
#define EPI_VARS(NI) const int tid = otid(), lane = tid & 63, wave = tid >> 6, l15 = lane & 15, quad = lane >> 4, wr = wave >> 1, wc = wave & 1; (void)tid
#define EPI_MN(NI) const int m = m0 + wr * 64 + mi * 16 + l15, n = n0 + wc * (16 * NI) + ni * 16 + quad * 4
__global__ void __launch_bounds__(NTHREADS, 2) fwd_megakernel(Params Parg) {
    extern __shared__ __attribute__((aligned(16))) unsigned char smem[];
    __shared__ uint4 xb_words;
    __shared__ unsigned qslot;
    const int bid = blockIdx.x, G = gridDim.x;
    if (threadIdx.x == 0) xb_words = make_uint4(0u, 0u, 0u, 0u);
    __syncthreads();
    XcdBarrier xb = xcd_barrier_post((unsigned*)(Parg.ws + WS_BAR), (volatile LAS unsigned*)&xb_words);
    Params* gp = (Params*)(Parg.ws + WS_BAR + 14336);
    if (threadIdx.x == 0) *gp = Parg;
    __threadfence();
    __syncthreads();
    if (Parg.out == nullptr) cg::this_grid().sync();
    const Params& P = *gp;

    float* MOD = (float*)(P.ws + WS_MOD);
    bf16* WB = (bf16*)(P.ws + WS_WB);
    bf16* H = (bf16*)(P.ws + WS_H);
    bf16* RA = (bf16*)(P.ws + WS_RA);
    bf16* YS = (bf16*)(P.ws + WS_RB);
    bf16* Z = (bf16*)(P.ws + WS_RC);
    bf16* A2 = (bf16*)(P.ws + WS_RC);
    bf16* YT = (bf16*)(P.ws + WS_YT);

    for (int it = bid; it < 384; it += G) mod_item(P, it, smem);
    conv_items(P, 0, bid, G, smem);
    GSYNC();
    { const int tid = otid(), lane = tid & 63, wave = tid >> 6, l15 = lane & 15, quad = lane >> 4; (void)tid; (void)l15; (void)quad;
    for (int r = bid * 4 + wave; r < T; r += G * 4) {
        const float* src = r < CTX ? P.in[2] + (size_t)r * D : P.in[0] + (size_t)(r - CTX) * D;
        const float* md = MOD + (size_t)(r < CTX ? 0 : 1) * 6144;
        ln_row(src, xrowp(P, r), nullptr, nullptr, md + 1024, md, H + (size_t)r * D, lane);
    } }
    GSYNC();

    for (int l = 0; l < DEPTH; ++l) {
        const float* modl = MOD + (size_t)l * 2 * 6144;
        const int tm0 = (l == DEPTH - 1) ? 2 : 0, ntm = 130 - tm0;
        for (int rep = 0; rep < NREP(0); ++rep)
            gemm_tiles<8>(bid, G, 0, WIN, true, [&](auto nic, int tm, int n0) {
                constexpr int NI = decltype(nic)::value; const int m0 = tm * 128;
                AccT<NI> acc; acc_zero(acc);
                gemm_k<NI>(acc, H + (size_t)m0 * D, D, WB + WB_WIN + (size_t)n0 * D, D, D, smem);
                EPI_VARS(NI);
#pragma unroll
                for (int mi = 0; mi < 4; ++mi)
#pragma unroll
                    for (int ni = 0; ni < NI; ++ni) { EPI_MN(NI);
                        *(u32x2*)(RA + (size_t)m * WIN + n) = pack4(acc.v[mi][ni][0], acc.v[mi][ni][1], acc.v[mi][ni][2], acc.v[mi][ni][3]); }
            });
        PHASE_END(1);
        {
            constexpr int N_RW = NT * 2, N_S5 = NT * 8, N_GL = NT * 8, N_LR = NT * 8, N_ALL = N_RW + N_S5 + N_GL + N_LR;
            unsigned* qctr = (unsigned*)(Parg.ws + WS_BAR + 15360) + 8 + l;
            for (;;) {
                __syncthreads();
                if (threadIdx.x == 0) qslot = __hip_atomic_fetch_add(qctr, 1u, __ATOMIC_RELAXED, __HIP_MEMORY_SCOPE_AGENT);
                __syncthreads();
                int r = (int)qslot;
                if (r >= N_ALL) break;
                if (r < N_RW) { PHX(0, rw_prep(P, l, r, smem)); continue; } r -= N_RW;
                if (r < N_GL) { PHX(1, gla_passA(P, l, r, smem)); continue; } r -= N_GL;
                if (r < N_LR) { PHX(2, lru_pass<0>(P, l, r, smem)); continue; } r -= N_LR;
                PHX(3, s5_passA(P, l, r, smem));
            }
        }
        PHASE_END(2);
        for (int rep = 0; rep < NREP(2); ++rep) for (int it = bid; it < 512; it += G) {
            if (it < 448) {
                const int mode = it / 224, u = it % 224, hd = u / 14, rem = u % 14, unit = ((hd * NSEG + (rem >> 1)) * 2 + (rem & 1));
                if (mode == 0) { PHX(4, rw_scan<0>(P, l, unit, smem)); } else { PHX(4, rw_scan<1>(P, l, unit, smem)); }
            } else if (rep == 0) {
                const int u = it - 448;
                PHX(5, gla_carry(P, u));
                if (u < 16) { PHX(6, s5_carry(P, l, u)); }
                else if (u < 20) { PHX(7, lru_carry(P, u - 16)); }
            }
        }
        xcd_barrier(xb);
        {
            for (int rep = 0; rep < NREP(2); ++rep) for (int it = bid; it < 256; it += G) { PHX(4, rw_scan<2>(P, l, it, smem)); }
            const int og = tm0 ? 16 : 0, o8 = tm0 ? 32 : 0;
            const int N_S5 = NT * 8 - o8, N_GL = NT * 4 - og, N_LR = NT * 8 - o8, N_Q = N_S5 + N_GL + N_LR;
            unsigned* qctr = (unsigned*)(Parg.ws + WS_BAR + 15360) + l;
            for (;;) {
                __syncthreads();
                if (threadIdx.x == 0) qslot = __hip_atomic_fetch_add(qctr, 1u, __ATOMIC_RELAXED, __HIP_MEMORY_SCOPE_AGENT);
                __syncthreads();
                int r = (int)qslot;
                if (r >= N_Q) break;
                if (r < N_GL) { PHX(10, gla_passC(P, l, r + og, smem)); continue; } r -= N_GL;
                if (r < N_S5) { PHX(9, s5_passC(P, l, r + o8, smem)); continue; } r -= N_S5;
                PHX(11, lru_pass<1>(P, l, r + o8, smem));
            }
        }
        PHASE_END(3);
        for (int it = bid + (tm0 ? 8 : 0); it < NT * 2; it += G) { PHX(8, rw_passC(P, l, it, smem)); }
        PHASE_END(4);
        for (int rep = 0; rep < ((DUPMASK & 0x10000) ? 2 : 1); ++rep) {
            const int nb = gemm_tiles<8>(bid, G, 0, 4096, tm0 == 0, [&](auto nic, int tm, int n0) {
                constexpr int NI = decltype(nic)::value; const int m0 = tm * 128;
                AccT<NI> acc; acc_zero(acc);
                gemm_k<NI>(acc, H + (size_t)m0 * D, D, WB + WB_WG + (size_t)n0 * D, D, D, smem);
                EPI_VARS(NI);
#pragma unroll
                for (int mi = 0; mi < 4; ++mi)
#pragma unroll
                    for (int ni = 0; ni < NI; ++ni) { EPI_MN(NI);
                        const f32x4 bg = *(const f32x4*)(P.in[43] + (size_t)l * 4096 + n);
                        *(u32x2*)(RA + (size_t)m * 4096 + n) = pack4(sigm(acc.v[mi][ni][0] + bg[0]), sigm(acc.v[mi][ni][1] + bg[1]), sigm(acc.v[mi][ni][2] + bg[2]), sigm(acc.v[mi][ni][3] + bg[3])); }
            });
            gemm_tiles<4>(bid, G, nb, 512, tm0 == 0, [&](auto nic, int tm, int n0) {
                constexpr int NI = decltype(nic)::value; const int m0 = tm * 128;
                AccT<NI> acc; acc_zero(acc);
                gemm_kloop<NI>(acc, YT + (size_t)m0 * 512, 512, WB + WB_GLU + (size_t)n0 * 512, 512, 512, smem);
                EPI_VARS(NI);
#pragma unroll
                for (int mi = 0; mi < 4; ++mi)
#pragma unroll
                    for (int ni = 0; ni < NI; ++ni) { EPI_MN(NI);
                        float y[4]; unpack4(*(const u32x2*)(YT + (size_t)m * 512 + n), y);
                        *(u32x2*)(YS + (size_t)m * 2048 + n) = pack4(y[0] * sigm(acc.v[mi][ni][0]), y[1] * sigm(acc.v[mi][ni][1]), y[2] * sigm(acc.v[mi][ni][2]), y[3] * sigm(acc.v[mi][ni][3])); }
            });
        }
        PHASE_END(5);
        for (int rep = 0; rep < ((DUPMASK & 0x4000) ? 2 : 1); ++rep)
            gemm_tiles<4>(bid, G, 0, D, tm0 == 0, [&](auto nic, int tm, int n0) {
                constexpr int NI = decltype(nic)::value; const int m0 = tm * 128;
                AccT<NI> zacc; acc_zero(zacc);
#pragma unroll 1
                for (int nb = 0; nb < 4; ++nb) {
                    AccT<NI> acc; acc_zero(acc);
                    if constexpr (NI == 4) gemm_kloopw<4>(acc, YS + (size_t)m0 * 2048 + nb * 512, 2048, WB + WB_WBR + (size_t)nb * 1024 * 512 + (size_t)n0 * 512, 512, 512, smem);
                    else gemm_kloop<NI>(acc, YS + (size_t)m0 * 2048 + nb * 512, 2048, WB + WB_WBR + (size_t)nb * 1024 * 512 + (size_t)n0 * 512, 512, 512, smem);
                    EPI_VARS(NI);
#pragma unroll
                    for (int mi = 0; mi < 4; ++mi)
#pragma unroll
                        for (int ni = 0; ni < NI; ++ni) { EPI_MN(NI);
                            float gt[4]; unpack4(*(const u32x2*)(RA + (size_t)m * 4096 + nb * 1024 + n), gt);
#pragma unroll
                            for (int r = 0; r < 4; ++r) zacc.v[mi][ni][r] += gt[r] * acc.v[mi][ni][r]; }
                }
                EPI_VARS(NI);
#pragma unroll
                for (int mi = 0; mi < 4; ++mi)
#pragma unroll
                    for (int ni = 0; ni < NI; ++ni) { EPI_MN(NI);
                        *(u32x2*)(Z + (size_t)m * D + n) = pack4(zacc.v[mi][ni][0], zacc.v[mi][ni][1], zacc.v[mi][ni][2], zacc.v[mi][ni][3]); }
            });
        PHASE_END(6);
        gemm_tiles<8>(bid, G, 0, D, tm0 == 0, [&](auto nic, int tm, int n0) {
            constexpr int NI = decltype(nic)::value; const int m0 = tm * 128;
            AccT<NI> acc; acc_zero(acc);
            gemm_k<NI>(acc, Z + (size_t)m0 * D, D, WB + WB_WOUT + (size_t)n0 * D, D, D, smem);
            EPI_VARS(NI);
            const float* md = modl + (size_t)(m0 < CTX ? 0 : 1) * 6144 + 2048;
#pragma unroll
            for (int mi = 0; mi < 4; ++mi)
#pragma unroll
                for (int ni = 0; ni < NI; ++ni) { EPI_MN(NI);
                    float* xp = xrowp(P, m) + n;
                    const f32x4 g = *(const f32x4*)(md + n), x = *(const f32x4*)xp;
                    *(f32x4*)xp = x * DN_ALPHA + g * acc.v[mi][ni]; }
        });
        PHASE_END(7);
        { const int tid = otid(), lane = tid & 63, wave = tid >> 6, l15 = lane & 15, quad = lane >> 4; (void)tid; (void)l15; (void)quad;
        for (int r = tm0 * 128 + bid * 4 + wave; r < T; r += G * 4) {
            const float* md = modl + (size_t)(r < CTX ? 0 : 1) * 6144;
            float* xp = xrowp(P, r);
            ln_row(xp, xp, P.in[45] + (size_t)l * D, P.in[46] + (size_t)l * D, md + 4096, md + 3072, H + (size_t)r * D, lane);
        } }
        PHASE_END(8);
        for (int rep = 0; rep < ((DUPMASK & 0x8000) ? 2 : 1); ++rep) {
            const int nb5 = gemm_tiles<4>(bid, G, 0, 2 * FF, false, [&](auto nic, int tm, int n0) {
                constexpr int NI = decltype(nic)::value;
                if constexpr (NI == 4) {
                    const int m0 = tm * 128, f0 = n0 >> 1;
                    AccT<4> acc; acc_zero(acc);
                    gemm_kloop<4, 1>(acc, H + (size_t)m0 * D, D, WB + WB_WUP + (size_t)f0 * D, D, D, smem);
                    EPI_VARS(4);
#pragma unroll
                    for (int ni = 0; ni < 2; ++ni) {
                        const int f = f0 + wc * 32 + ni * 16 + quad * 4;
                        const f32x4 cw0 = *(const f32x4*)(P.in[50] + ((size_t)l * 3 + 0) * FF + f), cw1 = *(const f32x4*)(P.in[50] + ((size_t)l * 3 + 1) * FF + f), cw2 = *(const f32x4*)(P.in[50] + ((size_t)l * 3 + 2) * FF + f);
                        const f32x4 cb = *(const f32x4*)(P.in[51] + (size_t)l * FF + f);
#pragma unroll
                        for (int mi = 0; mi < 4; ++mi) {
                            const int m = m0 + wr * 64 + mi * 16 + l15;
                            float o[4];
#pragma unroll
                            for (int r = 0; r < 4; ++r) {
                                const float uc = acc.v[mi][ni][r];
                                float up = __int_as_float(__builtin_amdgcn_update_dpp(0, __float_as_int(uc), 0x111, 0xF, 0xF, true));
                                float un = __int_as_float(__builtin_amdgcn_update_dpp(0, __float_as_int(uc), 0x101, 0xF, 0xF, true));
                                if (mi > 0) { const float w = __int_as_float(__builtin_amdgcn_update_dpp(0, __float_as_int(acc.v[mi > 0 ? mi - 1 : 0][ni][r]), 0x121, 0xF, 0xF, true)); up = (l15 == 0) ? w : up; }
                                if (mi < 3) { const float w = __int_as_float(__builtin_amdgcn_update_dpp(0, __float_as_int(acc.v[mi < 3 ? mi + 1 : 3][ni][r]), 0x12F, 0xF, 0xF, true)); un = (l15 == 15) ? w : un; }
                                const float y = cb[r] + cw0[r] * up + cw1[r] * uc + cw2[r] * un;
                                o[r] = gelu_t(y) * acc.v[mi][ni + 2][r];
                            }
                            *(u32x2*)(A2 + (size_t)m * FF + f) = pack4(o[0], o[1], o[2], o[3]);
                        }
                    }
                }
            });
            gemm_tiles<4>(bid, G, nb5, 2 * FF, tm0 == 0, [&](auto nic, int tm, int n0) {
                constexpr int NI = decltype(nic)::value; const int m0 = tm * 128;
                AccT<NI> acc; acc_zero(acc);
                gemm_kloop<NI>(acc, H + (size_t)m0 * D, D, WB + WB_WUP + (size_t)n0 * D, D, D, smem);
                EPI_VARS(NI);
#pragma unroll
                for (int mi = 0; mi < 4; ++mi)
#pragma unroll
                    for (int ni = 0; ni < NI; ++ni) { EPI_MN(NI);
                        *(u32x2*)(RA + (size_t)m * 5632 + n) = pack4(acc.v[mi][ni][0], acc.v[mi][ni][1], acc.v[mi][ni][2], acc.v[mi][ni][3]); }
            }, false);
        }
        PHASE_END(9);
        for (int rep = 0; rep < ((DUPMASK & 0x1000) ? 2 : 1); ++rep) for (size_t idx = (size_t)tm0 * 128 * 352 + (size_t)bid * 256 + otid(); idx < (size_t)CTX * 352; idx += (size_t)G * 256) {
            const int t = (int)(idx / 352), f = (int)(idx % 352) * 8;
            const int seglo = t < CTX ? 0 : (t & ~63), seghi = t < CTX ? CTX : seglo + 64;
            const bf16* u0 = RA + (size_t)t * 5632 + f;
            const u32x4 uc = *(const u32x4*)u0, vv = *(const u32x4*)(u0 + FF);
            u32x4 um = (u32x4){0u, 0u, 0u, 0u}, up = (u32x4){0u, 0u, 0u, 0u};
            if (t > seglo) um = *(const u32x4*)(u0 - 5632);
            if (t + 1 < seghi) up = *(const u32x4*)(u0 + 5632);
            const float* cw = P.in[50] + (size_t)l * 3 * FF + f; const float* cbp = P.in[51] + (size_t)l * FF + f;
            u32x4 o;
#pragma unroll
            for (int i = 0; i < 4; ++i) {
                const float y0 = cbp[2 * i] + cw[2 * i] * bflo(um[i]) + cw[FF + 2 * i] * bflo(uc[i]) + cw[2 * FF + 2 * i] * bflo(up[i]);
                const float y1 = cbp[2 * i + 1] + cw[2 * i + 1] * bfhi(um[i]) + cw[FF + 2 * i + 1] * bfhi(uc[i]) + cw[2 * FF + 2 * i + 1] * bfhi(up[i]);
                o[i] = pk2(gelu_t(y0) * bflo(vv[i]), gelu_t(y1) * bfhi(vv[i]));
            }
            *(u32x4*)(A2 + (size_t)t * FF + f) = o;
        }
        PHASE_END(10);
        gemm_tiles<8>(bid, G, 0, D, tm0 == 0, [&](auto nic, int tm, int n0) {
            constexpr int NI = decltype(nic)::value; const int m0 = tm * 128;
            AccT<NI> acc; acc_zero(acc);
            gemm_k<NI>(acc, A2 + (size_t)m0 * FF, FF, WB + WB_WDN + (size_t)n0 * FF, FF, FF, smem);
            EPI_VARS(NI);
            const float* md = modl + (size_t)(m0 < CTX ? 0 : 1) * 6144 + 5120;
#pragma unroll
            for (int mi = 0; mi < 4; ++mi)
#pragma unroll
                for (int ni = 0; ni < NI; ++ni) { EPI_MN(NI);
                    float* xp = xrowp(P, m) + n;
                    const f32x4 g = *(const f32x4*)(md + n), x = *(const f32x4*)xp;
                    *(f32x4*)xp = x * DN_ALPHA + g * acc.v[mi][ni]; }
        });
        PHASE_END(11);
        {
            const float* modn = MOD + (size_t)(l + 1 < DEPTH ? l + 1 : l) * 2 * 6144;
            const int tid = otid(), lane = tid & 63, wave = tid >> 6, l15 = lane & 15, quad = lane >> 4; (void)tid; (void)l15; (void)quad;
            for (int r = tm0 * 128 + bid * 4 + wave; r < T; r += G * 4) {
                const float* md = modn + (size_t)(r < CTX ? 0 : 1) * 6144;
                float* xp = xrowp(P, r);
                ln_row(xp, xp, P.in[47] + (size_t)l * D, P.in[48] + (size_t)l * D, md + 1024, md, (l + 1 < DEPTH) ? H + (size_t)r * D : nullptr, lane);
            }
            for (int rep = 0; rep < ((DUPMASK & 0x2000) ? 2 : 1); ++rep) if (l + 1 < DEPTH) conv_items(P, l + 1, bid, G, smem);
        }
        if (l + 1 < DEPTH) GSYNC();
    }
}

extern "C" void kernel_launch(void* const* d_in, const int* in_sizes, int n_in, void* d_out, int out_size, void* d_ws, size_t ws_size, hipStream_t stream) {
    static int grid_blocks = 0;
    if (!grid_blocks) {
        if (n_in != 53 || ws_size < WS_END) { fprintf(stderr, "kernel_launch: unexpected n_in %d or ws_size %zu (< %zu)\n", n_in, ws_size, (size_t)WS_END); }
        int dev = 0, cus = 0, per_cu = 0;
        hipGetDevice(&dev);
        hipDeviceGetAttribute(&cus, hipDeviceAttributeMultiprocessorCount, dev);
        hipFuncSetAttribute((const void*)fwd_megakernel, hipFuncAttributeMaxDynamicSharedMemorySize, LDS_BYTES);
        hipOccupancyMaxActiveBlocksPerMultiprocessor(&per_cu, (const void*)fwd_megakernel, NTHREADS, LDS_BYTES);
        if (per_cu > 2) per_cu = 2;
        if (per_cu < 1) per_cu = 1;
        grid_blocks = cus * per_cu;
    }
    hipMemsetAsync((char*)d_ws + WS_BAR, 0, 16384, stream);
    Params p{};
    for (int i = 0; i < 53; ++i) p.in[i] = (const float*)d_in[i];
    p.out = (float*)d_out; p.ws = (unsigned char*)d_ws;
    void* args[] = {&p};
    hipError_t e = hipLaunchCooperativeKernel((const void*)fwd_megakernel, dim3(grid_blocks), dim3(NTHREADS), args, LDS_BYTES, stream);
    if (e != hipSuccess) fprintf(stderr, "cooperative launch failed: %s (grid %d)\n", hipGetErrorString(e), grid_blocks);
}
```
